# Optimizing an MI355X kernel written in HIP

```python
import math
import jax
import jax.numpy as jnp
from jax import lax
import numpy as np

D_MODEL = 2048
BATCH = 4
SEQ = 8192
DEPTH = 2

GRID_W = 64
CTX_LEN = 256
MIX_WIDTH = D_MODEL
S5_WIDTH = MIX_WIDTH // 2
S5_GROUP = 16
S5_GROUPS = S5_WIDTH // S5_GROUP
S5_STATE = 64
NA_WIDTH = MIX_WIDTH - S5_WIDTH
NA_HEAD_DIM = 64
NA_HEADS = NA_WIDTH // NA_HEAD_DIM
NA_ROWS = 8
NA_COLS = 16
SGU_WIDTH = MIX_WIDTH // 2
SGU_HEADS = 8
SGU_CHUNK = 128
RWKV_WIDTH = MIX_WIDTH - SGU_WIDTH
RWKV_HEAD_DIM = 64
RWKV_HEADS = RWKV_WIDTH // RWKV_HEAD_DIM
RWKV_DECAY_RANK = 64
RWKV_A_RANK = 64
RWKV_GATE_RANK = 128
MLP_HIDDEN = 4 * D_MODEL
N_EVEN = (DEPTH + 1) // 2
N_ODD = DEPTH // 2
EVEN_IN = S5_WIDTH + 3 * NA_WIDTH
ODD_IN = 2 * SGU_WIDTH + 4 * RWKV_WIDTH
NORM_EPS = 1e-6
LN_EPS = 1e-5
RWKV_GN_EPS = 64e-5

kernel_name = 'hybrid_s5_natten_sgu_rwkv7_dit'


def rms_norm(x, g):
    xf = x.astype(jnp.float32)
    y = xf * lax.rsqrt(jnp.mean(xf * xf, axis=-1, keepdims=True) + NORM_EPS)
    return (y * g.astype(jnp.float32)).astype(x.dtype)


def layer_norm(x, g, b):
    xf = x.astype(jnp.float32)
    mu = jnp.mean(xf, axis=-1, keepdims=True)
    var = jnp.mean(jnp.square(xf - mu), axis=-1, keepdims=True)
    y = (xf - mu) * lax.rsqrt(var + LN_EPS)
    return (y * g.astype(jnp.float32) + b.astype(jnp.float32)).astype(x.dtype)


def ada_params(act, w_mod, b_mod):
    return jnp.split(act @ w_mod + b_mod, 6, axis=-1)


def modulate(x, g, shift, scale):
    return rms_norm(x, g) * (1 + scale) + shift


def gated_residual(x, y, g_post, gate):
    return x + gate * rms_norm(y, g_post)


def squared_relu_mlp(h, w_1, w_2):
    return jnp.square(jax.nn.relu(h @ w_1)) @ w_2


def s5_discretise(a_re, a_im, log_dt, b_re, b_im):
    lam = lax.complex(a_re.astype(jnp.float32), a_im.astype(jnp.float32))
    dt = jnp.exp(log_dt.astype(jnp.float32))[:, None]
    lam_bar = jnp.exp(lam * dt)
    b = lax.complex(b_re.astype(jnp.float32), b_im.astype(jnp.float32))
    b_bar = ((lam_bar - 1.0) / lam)[..., None] * b
    return lam_bar, b_bar


def s5_scan(lam_bar, bu, h0, reverse):
    edge = -1 if reverse else 0
    bu = bu.at[edge].add(lam_bar * h0)
    a = jnp.broadcast_to(lam_bar, (bu.shape[0], 1) + lam_bar.shape)

    def combine(e1, e2):
        a1, b1 = e1
        a2, b2 = e2
        return a1 * a2, a2 * b1 + b2

    _, xs = lax.associative_scan(combine, (a, bu), reverse=reverse)
    return xs


def s5_bidirectional(u, s5p, h0_fwd, h0_bwd):
    a_re, a_im, log_dt, b_re, b_im, c_re, c_im, d_skip = s5p
    bn, seq_len, _ = u.shape
    ug = u.astype(jnp.float32).reshape(bn, seq_len, S5_GROUPS, S5_GROUP)
    y = d_skip.astype(jnp.float32) * ug
    finals = []
    for direction, h0 in enumerate((h0_fwd, h0_bwd)):
        lam_bar, b_bar = s5_discretise(a_re[direction], a_im[direction], log_dt[direction],
                                       b_re[direction], b_im[direction])
        bu = jnp.einsum('blgp,gnp->lbgn', ug, b_bar)
        xs = s5_scan(lam_bar, bu, h0, reverse=direction == 1)
        c_mat = lax.complex(c_re[direction].astype(jnp.float32), c_im[direction].astype(jnp.float32))
        y = y + jnp.real(jnp.einsum('lbgn,gpn->blgp', xs, c_mat))
        finals.append(xs[0] if direction == 1 else xs[-1])
    return y, finals[0], finals[1]


def s5_glu(y, glu_w, glu_b, dtype):
    y = jax.nn.gelu(y)
    val = jnp.einsum('blgp,gpq->blgq', y, glu_w[0].astype(jnp.float32)) + glu_b[0]
    gate = jnp.einsum('blgp,gpq->blgq', y, glu_w[1].astype(jnp.float32)) + glu_b[1]
    bn, seq_len = y.shape[:2]
    return (val * jax.nn.sigmoid(gate)).reshape(bn, seq_len, S5_WIDTH).astype(dtype)


def neighbourhood_attention(q, k, v, k_ctx, v_ctx, rpb):
    bn, seq_len, _ = q.shape
    rows = seq_len // GRID_W
    kr = min(NA_ROWS, rows)
    grid = lambda t: t.reshape(bn, rows, GRID_W, NA_HEADS, NA_HEAD_DIM)
    qg, kg, vg = grid(q * NA_HEAD_DIM ** -0.5), grid(k), grid(v)
    kc = k_ctx.reshape(bn, -1, NA_HEADS, NA_HEAD_DIM)
    vc = v_ctx.reshape(bn, -1, NA_HEADS, NA_HEAD_DIM)
    cols = jnp.arange(GRID_W)
    col_start = jnp.clip(cols - NA_COLS // 2, 0, GRID_W - NA_COLS)
    col_in = (cols[None, :] >= col_start[:, None]) & (cols[None, :] < col_start[:, None] + NA_COLS)
    dc_idx = jnp.clip(cols[None, :] - cols[:, None] + NA_COLS - 1, 0, 2 * NA_COLS - 2)
    n_band = kr * GRID_W

    def row_block(r):
        start = jnp.clip(r - kr // 2, 0, rows - kr)
        q_r = lax.dynamic_index_in_dim(qg, r, axis=1, keepdims=False)
        k_b = lax.dynamic_slice_in_dim(kg, start, kr, axis=1)
        v_b = lax.dynamic_slice_in_dim(vg, start, kr, axis=1)
        dr_idx = start + jnp.arange(kr) - r + NA_ROWS - 1
        bias = rpb[:, dr_idx[:, None, None], dc_idx[None]]
        s_band = (jnp.einsum('bqhd,brkhd->bhqrk', q_r, k_b).astype(jnp.float32)
                  + jnp.transpose(bias, (0, 2, 1, 3)).astype(jnp.float32))
        s_band = jnp.where(col_in[:, None, :], s_band, -jnp.inf)
        s_ctx = jnp.einsum('bqhd,bchd->bhqc', q_r, kc).astype(jnp.float32)
        s = jnp.concatenate([s_band.reshape(bn, NA_HEADS, GRID_W, n_band), s_ctx], axis=-1)
        p = jax.nn.softmax(s, axis=-1).astype(v.dtype)
        p_band = p[..., :n_band].reshape(bn, NA_HEADS, GRID_W, kr, GRID_W)
        return (jnp.einsum('bhqrk,brkhd->bqhd', p_band, v_b)
                + jnp.einsum('bhqc,bchd->bqhd', p[..., n_band:], vc))

    out = lax.map(row_block, jnp.arange(rows))
    return jnp.moveaxis(out, 0, 1).reshape(bn, seq_len, NA_WIDTH)


def context_attention(q, k, v):
    bn, n, _ = q.shape
    heads = lambda t: t.reshape(bn, n, NA_HEADS, NA_HEAD_DIM)
    s = jnp.einsum('bqhd,bkhd->bhqk', heads(q), heads(k)).astype(jnp.float32) * NA_HEAD_DIM ** -0.5
    p = jax.nn.softmax(s, axis=-1).astype(v.dtype)
    return jnp.einsum('bhqk,bkhd->bqhd', p, heads(v)).reshape(bn, n, NA_WIDTH)


def chunk_spatial_gating(uv, ln_g, ln_b, w_s, b_s):
    bn, seq_len, _ = uv.shape
    u, v = jnp.split(jax.nn.gelu(uv), 2, axis=-1)
    v = layer_norm(v, ln_g, ln_b)
    v = v.reshape(bn, seq_len // SGU_CHUNK, SGU_CHUNK, SGU_HEADS, SGU_WIDTH // SGU_HEADS)
    mixed = jnp.einsum('hpq,bnqhc->bnphc', w_s, v) + b_s.T[:, :, None]
    return u * mixed.reshape(bn, seq_len, SGU_WIDTH)


def token_shift(z):
    zp = jnp.pad(z, ((0, 0), (1, 1), (0, 0)))
    return 0.5 * (zp[:, :-2] + zp[:, 2:]) - z


def rwkv7_scan(r, w, k, v, kk, a, s0, reverse):
    xs = tuple(jnp.moveaxis(t.astype(jnp.float32), 1, 0) for t in (r, w, k, v, kk, a))

    def step(state, inp):
        r_t, w_t, k_t, v_t, kk_t, a_t = inp
        state = (state * w_t[..., None, :]
                 - jnp.einsum('bhvk,bhk->bhv', state, kk_t)[..., None] * (kk_t * a_t)[..., None, :]
                 + v_t[..., :, None] * k_t[..., None, :])
        return state, jnp.einsum('bhvk,bhk->bhv', state, r_t)

    s_final, ys = lax.scan(step, s0, xs, reverse=reverse)
    return jnp.moveaxis(ys, 0, 1), s_final


def rwkv7_time_mix(zr, s0_fwd, s0_bwd, rp):
    mu, w0, w1, w2, a0, a1, a2, g1, g2, k_k, k_a, r_k, ln_g, ln_b = rp
    bn, seq_len, _ = zr.shape
    heads = lambda t: t.reshape(bn, seq_len, RWKV_HEADS, RWKV_HEAD_DIM)
    r, k, v, xd = jnp.split(zr, 4, axis=-1)
    dr, dk, dv, dxd = jnp.split(token_shift(zr), 4, axis=-1)
    r, k, v = r + mu[0] * dr, k + mu[1] * dk, v + mu[2] * dv
    xw, xa, xg = xd + mu[3] * dxd, xd + mu[4] * dxd, xd + mu[5] * dxd
    kk = heads(k * k_k).astype(jnp.float32)
    kk = kk / jnp.maximum(jnp.sqrt(jnp.sum(kk * kk, axis=-1, keepdims=True)), 1e-12)
    y = 0.0
    bonus = 0.0
    finals = []
    for direction, s0 in enumerate((s0_fwd, s0_bwd)):
        w_log = -jax.nn.softplus(-(w0[direction] + jnp.tanh(xw @ w1[direction]) @ w2[direction])) - 0.5
        decay = jnp.exp(-jnp.exp(w_log.astype(jnp.float32)))
        a = jax.nn.sigmoid(a0[direction] + (xa @ a1[direction]) @ a2[direction])
        k_dir = k * (1 + (a - 1) * k_a)
        y_dir, s_final = rwkv7_scan(heads(r), heads(decay), heads(k_dir), heads(v), kk, heads(a),
                                    s0, direction == 1)
        y = y + y_dir
        bonus = bonus + jnp.sum(heads(r) * heads(k_dir) * r_k, axis=-1, keepdims=True) * heads(v)
        finals.append(s_final)
    mean = jnp.mean(y, axis=-1, keepdims=True)
    var = jnp.mean(jnp.square(y - mean), axis=-1, keepdims=True)
    y = ((y - mean) * lax.rsqrt(var + RWKV_GN_EPS)).reshape(bn, seq_len, RWKV_WIDTH) * ln_g + ln_b
    y = y + bonus.reshape(bn, seq_len, RWKV_WIDTH)
    g = jax.nn.sigmoid(xg @ g1) @ g2
    return (y * g).astype(zr.dtype), finals[0], finals[1]


def even_mixer(z, zc, s5p, glu_w, glu_b, rpb, ctx_out):
    cuts = [S5_WIDTH, S5_WIDTH + NA_WIDTH, S5_WIDTH + 2 * NA_WIDTH]
    u, q, k, v = jnp.split(z, cuts, axis=-1)
    u_c, q_c, k_c, v_c = jnp.split(zc, cuts, axis=-1)
    h_zero = jnp.zeros((zc.shape[0], S5_GROUPS, S5_STATE), jnp.complex64)
    y_c, h_fwd, h_bwd = s5_bidirectional(u_c, s5p, h_zero, h_zero)
    y, _, _ = s5_bidirectional(u, s5p, h_fwd, h_bwd)
    o = jnp.concatenate([s5_glu(y, glu_w, glu_b, z.dtype),
                         neighbourhood_attention(q, k, v, k_c, v_c, rpb)], axis=-1)
    if not ctx_out:
        return o, None
    oc = jnp.concatenate([s5_glu(y_c, glu_w, glu_b, zc.dtype), context_attention(q_c, k_c, v_c)], axis=-1)
    return o, oc


def odd_mixer(z, zc, ln_g, ln_b, w_s, b_s, rp, ctx_out):
    uv, zr = z[..., :2 * SGU_WIDTH], z[..., 2 * SGU_WIDTH:]
    uv_c, zr_c = zc[..., :2 * SGU_WIDTH], zc[..., 2 * SGU_WIDTH:]
    s_zero = jnp.zeros((zc.shape[0], RWKV_HEADS, RWKV_HEAD_DIM, RWKV_HEAD_DIM), jnp.float32)
    y_c, s_fwd, s_bwd = rwkv7_time_mix(zr_c, s_zero, s_zero, rp)
    y, _, _ = rwkv7_time_mix(zr, s_fwd, s_bwd, rp)
    o = jnp.concatenate([chunk_spatial_gating(uv, ln_g, ln_b, w_s, b_s), y], axis=-1)
    if not ctx_out:
        return o, None
    oc = jnp.concatenate([chunk_spatial_gating(uv_c, ln_g, ln_b, w_s, b_s), y_c], axis=-1)
    return o, oc


def setup_inputs(seed: int = 0) -> dict:
    key = jax.random.key(seed)
    keys = iter(jax.random.split(key, 64))
    f32 = jnp.float32

    def nrm(shape, scale):
        return scale * jax.random.normal(next(keys), shape, f32)

    def uni(shape, lo, hi):
        return jax.random.uniform(next(keys), shape, f32, lo, hi)

    d = D_MODEL
    s5_shape = (N_EVEN, 2, S5_GROUPS, S5_STATE)
    return {
        'x': nrm((BATCH, SEQ, d), 1.0),
        'c': nrm((BATCH, d), 1.0),
        'ctx': nrm((BATCH, CTX_LEN, d), 1.0),
        'c_ctx': nrm((d,), 1.0),
        'w_mod': nrm((DEPTH, d, 6 * d), 0.5 * d ** -0.5),
        'b_mod': nrm((DEPTH, 6 * d), 0.02),
        'norm_mix_pre': 1.0 + nrm((DEPTH, d), 0.02),
        'norm_mix_post': 1.0 + nrm((DEPTH, d), 0.02),
        'norm_mlp_pre': 1.0 + nrm((DEPTH, d), 0.02),
        'norm_mlp_post': 1.0 + nrm((DEPTH, d), 0.02),
        'w_in_even': nrm((N_EVEN, d, EVEN_IN), d ** -0.5),
        'w_in_odd': nrm((N_ODD, d, ODD_IN), d ** -0.5),
        'w_out': nrm((DEPTH, MIX_WIDTH, d), MIX_WIDTH ** -0.5),
        'w_mlp_in': nrm((DEPTH, d, MLP_HIDDEN), d ** -0.5),
        'w_mlp_out': nrm((DEPTH, MLP_HIDDEN, d), MLP_HIDDEN ** -0.5),
        's5_a_re': -0.5 + nrm(s5_shape, 0.01),
        's5_a_im': math.pi * jnp.arange(S5_STATE, dtype=f32) + nrm(s5_shape, 0.01),
        's5_log_dt': uni((N_EVEN, 2, S5_GROUPS), math.log(1e-3), math.log(1e-1)),
        's5_b_re': nrm((N_EVEN, 2, S5_GROUPS, S5_STATE, S5_GROUP), (2 * S5_GROUP) ** -0.5),
        's5_b_im': nrm((N_EVEN, 2, S5_GROUPS, S5_STATE, S5_GROUP), (2 * S5_GROUP) ** -0.5),
        's5_c_re': nrm((N_EVEN, 2, S5_GROUPS, S5_GROUP, S5_STATE), (2 * S5_STATE) ** -0.5),
        's5_c_im': nrm((N_EVEN, 2, S5_GROUPS, S5_GROUP, S5_STATE), (2 * S5_STATE) ** -0.5),
        's5_d': nrm((N_EVEN, S5_GROUPS, S5_GROUP), 1.0),
        's5_glu_w': nrm((N_EVEN, 2, S5_GROUPS, S5_GROUP, S5_GROUP), S5_GROUP ** -0.5),
        's5_glu_b': nrm((N_EVEN, 2, S5_GROUPS, S5_GROUP), 0.02),
        'na_rpb': nrm((N_EVEN, NA_HEADS, 2 * NA_ROWS - 1, 2 * NA_COLS - 1), 0.05),
        'sgu_ln_g': 1.0 + nrm((N_ODD, SGU_WIDTH), 0.02),
        'sgu_ln_b': nrm((N_ODD, SGU_WIDTH), 0.02),
        'sgu_w': nrm((N_ODD, SGU_HEADS, SGU_CHUNK, SGU_CHUNK), SGU_CHUNK ** -0.5),
        'sgu_b': 1.0 + nrm((N_ODD, SGU_HEADS, SGU_CHUNK), 0.02),
        'rwkv_mu': uni((N_ODD, 6, RWKV_WIDTH), 0.0, 1.0),
        'rwkv_w0': jnp.linspace(-6.0, -1.0, RWKV_WIDTH, dtype=f32) + nrm((N_ODD, 2, RWKV_WIDTH), 0.1),
        'rwkv_w1': nrm((N_ODD, 2, RWKV_WIDTH, RWKV_DECAY_RANK), RWKV_WIDTH ** -0.5),
        'rwkv_w2': nrm((N_ODD, 2, RWKV_DECAY_RANK, RWKV_WIDTH), 0.1 * RWKV_DECAY_RANK ** -0.5),
        'rwkv_a0': nrm((N_ODD, 2, RWKV_WIDTH), 0.1),
        'rwkv_a1': nrm((N_ODD, 2, RWKV_WIDTH, RWKV_A_RANK), RWKV_WIDTH ** -0.5),
        'rwkv_a2': nrm((N_ODD, 2, RWKV_A_RANK, RWKV_WIDTH), 0.1 * RWKV_A_RANK ** -0.5),
        'rwkv_g1': nrm((N_ODD, RWKV_WIDTH, RWKV_GATE_RANK), RWKV_WIDTH ** -0.5),
        'rwkv_g2': nrm((N_ODD, RWKV_GATE_RANK, RWKV_WIDTH), RWKV_GATE_RANK ** -0.5),
        'rwkv_k_k': 0.85 + nrm((N_ODD, RWKV_WIDTH), 0.02),
        'rwkv_k_a': 1.0 + nrm((N_ODD, RWKV_WIDTH), 0.02),
        'rwkv_r_k': nrm((N_ODD, RWKV_HEADS, RWKV_HEAD_DIM), 0.1),
        'rwkv_ln_g': 1.0 + nrm((N_ODD, RWKV_WIDTH), 0.02),
        'rwkv_ln_b': nrm((N_ODD, RWKV_WIDTH), 0.02),
    }


def reference(x, c, ctx, c_ctx, w_mod, b_mod, norm_mix_pre, norm_mix_post, norm_mlp_pre, norm_mlp_post,
              w_in_even, w_in_odd, w_out, w_mlp_in, w_mlp_out,
              s5_a_re, s5_a_im, s5_log_dt, s5_b_re, s5_b_im, s5_c_re, s5_c_im, s5_d, s5_glu_w, s5_glu_b,
              na_rpb, sgu_ln_g, sgu_ln_b, sgu_w, sgu_b,
              rwkv_mu, rwkv_w0, rwkv_w1, rwkv_w2, rwkv_a0, rwkv_a1, rwkv_a2, rwkv_g1, rwkv_g2,
              rwkv_k_k, rwkv_k_a, rwkv_r_k, rwkv_ln_g, rwkv_ln_b):
    act = jax.nn.silu(c)[:, None, :]
    act_ctx = jax.nn.silu(c_ctx)
    xc = ctx
    for i in range(DEPTH):
        ctx_out = i < DEPTH - 1
        j = i // 2
        sh1, sc1, gt1, sh2, sc2, gt2 = ada_params(act, w_mod[i], b_mod[i])
        csh1, csc1, cgt1, csh2, csc2, cgt2 = ada_params(act_ctx, w_mod[i], b_mod[i])
        h = modulate(x, norm_mix_pre[i], sh1, sc1)
        hc = modulate(xc, norm_mix_pre[i], csh1, csc1)
        if i % 2 == 0:
            s5p = (s5_a_re[j], s5_a_im[j], s5_log_dt[j], s5_b_re[j], s5_b_im[j],
                   s5_c_re[j], s5_c_im[j], s5_d[j])
            o, oc = even_mixer(h @ w_in_even[j], hc @ w_in_even[j], s5p, s5_glu_w[j], s5_glu_b[j],
                               na_rpb[j], ctx_out)
        else:
            rp = (rwkv_mu[j], rwkv_w0[j], rwkv_w1[j], rwkv_w2[j], rwkv_a0[j], rwkv_a1[j], rwkv_a2[j],
                  rwkv_g1[j], rwkv_g2[j], rwkv_k_k[j], rwkv_k_a[j], rwkv_r_k[j], rwkv_ln_g[j], rwkv_ln_b[j])
            o, oc = odd_mixer(h @ w_in_odd[j], hc @ w_in_odd[j], sgu_ln_g[j], sgu_ln_b[j], sgu_w[j], sgu_b[j],
                              rp, ctx_out)
        x = gated_residual(x, o @ w_out[i], norm_mix_post[i], gt1)
        x = gated_residual(x, squared_relu_mlp(modulate(x, norm_mlp_pre[i], sh2, sc2), w_mlp_in[i], w_mlp_out[i]),
                           norm_mlp_post[i], gt2)
        if ctx_out:
            xc = gated_residual(xc, oc @ w_out[i], norm_mix_post[i], cgt1)
            xc = gated_residual(xc, squared_relu_mlp(modulate(xc, norm_mlp_pre[i], csh2, csc2),
                                                     w_mlp_in[i], w_mlp_out[i]), norm_mlp_post[i], cgt2)
    return x
```

```cpp
#include <hip/hip_runtime.h>
#include <hip/hip_cooperative_groups.h>
#include <cstdio>
#include <cstdint>
namespace cg = cooperative_groups;

#define LAS __attribute__((address_space(3)))
typedef unsigned short bf16_t;
typedef short bf16x8 __attribute__((ext_vector_type(8)));
typedef float f32x4 __attribute__((ext_vector_type(4)));
typedef unsigned u32x4 __attribute__((ext_vector_type(4)));
typedef unsigned u32x2 __attribute__((ext_vector_type(2)));

constexpr int DM = 2048, TL = 32768, TCX = 1024, TT = 33792, LSEQ = 8192, NCTX = 256;
constexpr size_t MiB = 1ull << 20;
constexpr size_t WB_WINE = 0, WB_WOUT0 = 16 * MiB, WB_W1_0 = 24 * MiB, WB_W2_0 = 56 * MiB, WB_WINO = 88 * MiB, WB_WOUT1 = 112 * MiB, WB_W1_1 = 120 * MiB, WB_W2_1 = 152 * MiB;
constexpr size_t OFF_R1 = 184 * MiB, OFF_R2 = 712 * MiB, OFF_R3 = 844 * MiB, OFF_SL = 976 * MiB;
constexpr size_t OFF_XC = OFF_SL, OFF_MOD = OFF_SL + 8 * MiB, OFF_BONUS = OFF_SL + 9 * MiB, OFF_L1T = OFF_SL + 14 * MiB, OFF_L2T = OFF_SL + 16 * MiB, OFF_WSB = OFF_SL + 20 * MiB, OFF_TBL = OFF_SL + 21 * MiB, WS_END = OFF_SL + 22 * MiB;
constexpr size_t OFF_VLNT = 0, OFF_G = 0, OFF_LORA1 = 72 * MiB;
constexpr size_t OFF_EWA = OFF_R1 + 396 * MiB;
constexpr size_t OFF_S5E = OFF_R2, OFF_VT = OFF_R2 + 34 * MiB, OFF_VCT = OFF_R2 + 98 * MiB;
constexpr int LDS_BYTES = 131072 + 16;
constexpr size_t OFF_BAR = OFF_TBL + 65536;

struct Params { const float* in[44]; float* out; unsigned char* ws; };
struct PP { const float* const* in; float* out; unsigned char* ws; };

typedef float f32x2_t __attribute__((ext_vector_type(2)));
typedef __bf16 bf16x2_t __attribute__((ext_vector_type(2)));
__device__ __forceinline__ unsigned cvt_pk_bf16(float lo, float hi) { const f32x2_t v = {lo, hi}; const bf16x2_t b = __builtin_convertvector(v, bf16x2_t); return __builtin_bit_cast(unsigned, b); }
__device__ __forceinline__ bf16_t f2bf(float f) { return (bf16_t)(cvt_pk_bf16(f, 0.f) & 0xffffu); }
__device__ __forceinline__ float bf2f(bf16_t b) { return __uint_as_float(((unsigned)b) << 16); }
__device__ __forceinline__ float bflo(unsigned u) { return __uint_as_float(u << 16); }
__device__ __forceinline__ float bfhi(unsigned u) { return __uint_as_float(u & 0xffff0000u); }
__device__ __forceinline__ float sigmoidf_(float x) { return 1.f / (1.f + __expf(-x)); }
__device__ __forceinline__ float gelu_tanh(float x) { const float u2 = 1.5957691216057308f * (x + 0.044715f * x * x * x); return x * __builtin_amdgcn_rcpf(1.f + __expf(-u2)); }
__device__ __forceinline__ float wave_sum(float v) {
#pragma unroll
    for (int o = 32; o > 0; o >>= 1) v += __shfl_xor(v, o);
    return v;
}
#define DPP_ADD(v, ctrl) (v) += __builtin_bit_cast(float, __builtin_amdgcn_update_dpp(0, __builtin_bit_cast(int, (v)), (ctrl), 0xf, 0xf, false))
#define DPP_MAX(v, ctrl) (v) = fmaxf((v), __builtin_bit_cast(float, __builtin_amdgcn_update_dpp(0, __builtin_bit_cast(int, (v)), (ctrl), 0xf, 0xf, false)))
__device__ __forceinline__ float sum16(float v) { DPP_ADD(v, 0xB1); DPP_ADD(v, 0x4E); DPP_ADD(v, 0x141); DPP_ADD(v, 0x128); return v; }
__device__ __forceinline__ float max16(float v) { DPP_MAX(v, 0xB1); DPP_MAX(v, 0x4E); DPP_MAX(v, 0x141); DPP_MAX(v, 0x128); return v; }
__device__ __forceinline__ int opaque_tid() { int t = threadIdx.x; asm volatile("" : "+v"(t)); return t; }
__device__ __forceinline__ int opaque_bid() { int t = blockIdx.x; asm volatile("" : "+s"(t)); return t; }
__device__ __forceinline__ void lam_bar_of(float are, float aim, float dt, float& lre, float& lim) { const float mag = __expf(are * dt); float sn, cs; __sincosf(aim * dt, &sn, &cs); lre = mag * cs; lim = mag * sn; }
#define WAVE_SYNC() asm volatile("s_waitcnt lgkmcnt(0)" ::: "memory")
__device__ __forceinline__ bf16x8 pack8(const float* v) {
    u32x4 r; r[0] = cvt_pk_bf16(v[0], v[1]); r[1] = cvt_pk_bf16(v[2], v[3]); r[2] = cvt_pk_bf16(v[4], v[5]); r[3] = cvt_pk_bf16(v[6], v[7]);
    return __builtin_bit_cast(bf16x8, r);
}
__device__ __forceinline__ bf16x8 pack8v(f32x4 a, f32x4 b) {
    u32x4 r; r[0] = cvt_pk_bf16(a[0], a[1]); r[1] = cvt_pk_bf16(a[2], a[3]); r[2] = cvt_pk_bf16(b[0], b[1]); r[3] = cvt_pk_bf16(b[2], b[3]);
    return __builtin_bit_cast(bf16x8, r);
}
#define MFMA16(a, b, c) __builtin_amdgcn_mfma_f32_16x16x32_bf16((a), (b), (c), 0, 0, 0)
__device__ __forceinline__ bf16x8 zero8() { u32x4 r = {0u, 0u, 0u, 0u}; return __builtin_bit_cast(bf16x8, r); }

namespace pg8 {
constexpr int BM = 256, BK = 64, HALF = 128, HTB = HALF * BK * 2, STAGE_BYTES = 8 * HTB, NXCD = 8, WGM = 8;
__host__ __device__ __forceinline__ int lds_byte(int r, int c) { const int st = (r >> 4) * 2 + (c >> 5), rr = r & 15, cc = c & 31, ob = rr * 64 + cc * 2; return st * 1024 + (ob ^ (((ob >> 9) & 1) << 5)); }
__host__ __device__ __forceinline__ void stage_rc(int b, int& R, int& C) { const int st = b / 1024, sb = b % 1024, swz = sb ^ (((sb >> 9) & 1) << 5); R = (st >> 1) * 16 + swz / 64; C = (st & 1) * 32 + (swz % 64) / 2; }
__host__ __device__ __forceinline__ int perm32(int rho) { const int n = rho >> 4, i = rho & 15; return 8 * (i >> 2) + 4 * n + (i & 3); }
struct Unit { int pm, pn; };
struct Gemm { const bf16_t* A; const bf16_t* Bt; int M, N, K; int lda; };
struct StaticOrder {
    int nM, nN, nwg, G, c;
    __host__ __device__ void init(int M, int N, int G_, int c_) { nM = M / BM; nN = N / BM; nwg = nM * nN; G = G_; c = c_; }
    __host__ __device__ bool next(int i, Unit& u) const {
        const long L = (long)i * G + c; if (L >= nwg) return false;
        int wgid = (int)L; { const int q = nwg / NXCD, r = nwg % NXCD, xcd = wgid % NXCD, off = wgid / NXCD; wgid = (xcd < r ? xcd * (q + 1) : r * (q + 1) + (xcd - r) * q) + off; }
        const int nig = WGM * nN, gid = wgid / nig, fm = gid * WGM, gsz = (nM - fm) < WGM ? (nM - fm) : WGM;
        u.pm = fm + ((wgid % nig) % gsz); u.pn = (wgid % nig) / gsz; return true;
    }
};

template <class Epi, class Sched>
__device__ __forceinline__ void gemm_phase(LAS unsigned char* lds, const Gemm g, const Sched& S, const Epi& E) {
    const int TIX = opaque_tid(); const int BIX = opaque_bid(); (void)TIX; (void)BIX;
    const int tid = TIX, wid = __builtin_amdgcn_readfirstlane(tid >> 6), lane = tid & 63, wr = wid >> 2, wc = wid & 3, fr = lane & 15, fq = lane >> 4;
    const int K = g.K, nt = K / BK;
    unsigned voffA[2], voffB[2];
#pragma unroll
    for (int i = 0; i < 2; ++i) { int R, C; stage_rc(tid * 16 + i * 8192, R, C); const int Rb = Epi::PERM ? ((R & ~31) + perm32(R & 31)) : R;
        voffA[i] = (unsigned)(R * g.lda + C) * 2u; voffB[i] = (unsigned)(Rb * K + C) * 2u; }
    const size_t kstep = (size_t)(BK * 2);
    const size_t hstep = (size_t)HALF * K * 2, hstepA = (size_t)HALF * g.lda * 2;
    const size_t tstep = 2 * hstep, tstepA = 2 * hstepA;
    const unsigned ldsw = (unsigned)wid * 1024u;
    const int aoff = lds_byte(wr * 64 + fr, fq * 8), boff = lds_byte(wc * 32 + fr, fq * 8);
#define PG8_SA(b, h) (((b) * 2 + (h)) * HTB)
#define PG8_SB(b, h) ((4 + (b) * 2 + (h)) * HTB)
#define PG8_STAGE(bufoff, gbase, voff) do { _Pragma("unroll") for (int _i = 0; _i < 2; ++_i) \
        __builtin_amdgcn_global_load_lds((const unsigned*)((const char*)(gbase) + (voff)[_i]), (LAS unsigned*)(lds + (bufoff) + ldsw + _i * 8192), 16, 0, 0); } while (0)
#define PG8_LDA(dst, b, h) do { _Pragma("unroll") for (int m = 0; m < 4; ++m) _Pragma("unroll") for (int k = 0; k < 2; ++k) dst[m][k] = *(const LAS bf16x8*)(lds + PG8_SA(b, h) + aoff + m * 2048 + k * 1024); } while (0)
#define PG8_LDB(dst, b, h) do { _Pragma("unroll") for (int n = 0; n < 2; ++n) _Pragma("unroll") for (int k = 0; k < 2; ++k) dst[n][k] = *(const LAS bf16x8*)(lds + PG8_SB(b, h) + boff + n * 2048 + k * 1024); } while (0)
#define PG8_MMA(ai, bj, At, Bt) do { __builtin_amdgcn_s_setprio(1); _Pragma("unroll") for (int m = 0; m < 4; ++m) _Pragma("unroll") for (int n = 0; n < 2; ++n) _Pragma("unroll") for (int k = 0; k < 2; ++k) \
        acc[ai][bj][m][n] = __builtin_amdgcn_mfma_f32_16x16x32_bf16(Bt[n][k], At[m][k], acc[ai][bj][m][n], 0, 0, 0); __builtin_amdgcn_s_setprio(0); } while (0)
#define PG8_WAIT_V(n) asm volatile("s_waitcnt vmcnt(" #n ")" ::: "memory")
#define PG8_WAIT_L(n) asm volatile("s_waitcnt lgkmcnt(" #n ")" ::: "memory")
#define PG8_BAR __builtin_amdgcn_s_barrier()
#define PG8_SCHED __builtin_amdgcn_sched_barrier(0)
    Unit cur, nxt; int ui = 0;
    if (!S.next(0, cur)) return;
    f32x4 acc[2][2][4][2];
#pragma unroll
    for (int a = 0; a < 2; ++a)
#pragma unroll
        for (int b = 0; b < 2; ++b)
#pragma unroll
            for (int m = 0; m < 4; ++m)
#pragma unroll
                for (int n = 0; n < 2; ++n) acc[a][b][m][n] = (f32x4){0.f, 0.f, 0.f, 0.f};
    bf16x8 At[4][2], B0[2][2], B1[2][2];
    const char* cA = (const char*)g.A + (size_t)cur.pm * tstepA; const char* cB = (const char*)g.Bt + (size_t)cur.pn * tstep;
    PG8_STAGE(PG8_SB(0, 0), cB, voffB); PG8_STAGE(PG8_SB(0, 1), cB + hstep, voffB); PG8_STAGE(PG8_SA(0, 0), cA, voffA); PG8_STAGE(PG8_SA(0, 1), cA + hstepA, voffA);
    if (wr == 1) PG8_BAR;
    PG8_WAIT_V(2); PG8_BAR;
    PG8_STAGE(PG8_SB(1, 0), cB + kstep, voffB); PG8_STAGE(PG8_SA(1, 0), cA + kstep, voffA); PG8_STAGE(PG8_SB(1, 1), cB + hstep + kstep, voffB);
    PG8_WAIT_V(6); PG8_BAR;
    for (;;) {
        const bool has_next = S.next(ui + 1, nxt);
        const char* nA = has_next ? (const char*)g.A + (size_t)nxt.pm * tstepA : cA; const char* nB = has_next ? (const char*)g.Bt + (size_t)nxt.pn * tstep : cB;
        for (int t = 0; t < nt; t += 2) {
            const bool last = (t == nt - 2);
            const char* a1 = cA + (size_t)(t + 1) * kstep;
            const char* a2 = last ? nA : cA + (size_t)(t + 2) * kstep; const char* b2 = last ? nB : cB + (size_t)(t + 2) * kstep;
            const char* a3 = a2 + kstep; const char* b3 = b2 + kstep;
            PG8_LDB(B0, 0, 0); PG8_LDB(B1, 0, 1); PG8_SCHED; PG8_LDA(At, 0, 0); PG8_STAGE(PG8_SA(1, 1), a1 + hstepA, voffA);
            PG8_WAIT_V(8); PG8_WAIT_L(0); PG8_BAR; PG8_MMA(0, 0, At, B0); PG8_MMA(0, 1, At, B1); PG8_BAR; PG8_SCHED;
            PG8_LDA(At, 0, 1); PG8_STAGE(PG8_SB(0, 0), b2, voffB); PG8_STAGE(PG8_SB(0, 1), b2 + hstep, voffB); PG8_STAGE(PG8_SA(0, 0), a2, voffA);
            PG8_WAIT_V(8); PG8_WAIT_L(0); PG8_BAR; PG8_MMA(1, 0, At, B0); PG8_MMA(1, 1, At, B1); PG8_BAR; PG8_SCHED;
            PG8_LDB(B0, 1, 0); PG8_LDB(B1, 1, 1); PG8_SCHED; PG8_LDA(At, 1, 0); PG8_STAGE(PG8_SA(0, 1), a2 + hstepA, voffA);
            PG8_WAIT_V(8); PG8_WAIT_L(0); PG8_BAR; PG8_MMA(0, 0, At, B0); PG8_MMA(0, 1, At, B1); PG8_BAR; PG8_SCHED;
            PG8_LDA(At, 1, 1); PG8_STAGE(PG8_SB(1, 0), b3, voffB); PG8_STAGE(PG8_SB(1, 1), b3 + hstep, voffB); PG8_STAGE(PG8_SA(1, 0), a3, voffA);
            PG8_WAIT_V(8); PG8_WAIT_L(0); PG8_BAR; PG8_MMA(1, 0, At, B0); PG8_MMA(1, 1, At, B1); PG8_BAR; PG8_SCHED;
        }
        if (wr == 0) PG8_BAR;
        E(acc, cur, wr, wc, fr, fq);
        if (!has_next) break;
#pragma unroll
        for (int a = 0; a < 2; ++a)
#pragma unroll
            for (int b = 0; b < 2; ++b)
#pragma unroll
                for (int m = 0; m < 4; ++m)
#pragma unroll
                    for (int n = 0; n < 2; ++n) acc[a][b][m][n] = (f32x4){0.f, 0.f, 0.f, 0.f};
        cur = nxt; cA = nA; cB = nB; ++ui;
        if (wr == 1) PG8_BAR;
    }
    PG8_WAIT_V(0);
    PG8_BAR;
#undef PG8_SA
#undef PG8_SB
#undef PG8_STAGE
#undef PG8_LDA
#undef PG8_LDB
#undef PG8_MMA
#undef PG8_WAIT_V
#undef PG8_WAIT_L
#undef PG8_BAR
#undef PG8_SCHED
}
}

enum { EPI_PLAIN = 0, EPI_RELU2 = 1, EPI_LORA1 = 2, EPI_LORA2 = 3 };
enum { SUB_PLAIN = 0, SUB_RELU2 = 1, SUB_TANH = 2, SUB_SIGM = 3, SUB_EW = 4, SUB_SIGB = 5 };
template <int SUB>
__device__ __forceinline__ void epi_half(const f32x4 (&acc)[2][2][4][2], int bj, bf16_t* dst0  , size_t ldc, const float* bias  ) {
    f32x4 b0 = {0.f, 0.f, 0.f, 0.f}, b1 = {0.f, 0.f, 0.f, 0.f};
    if (SUB == SUB_EW || SUB == SUB_SIGB) { b0 = *(const f32x4*)bias; b1 = *(const f32x4*)(bias + 4); }
#pragma unroll
    for (int ai = 0; ai < 2; ++ai)
#pragma unroll
        for (int m = 0; m < 4; ++m) {
            const f32x4 v0 = acc[ai][bj][m][0] + b0, v1 = acc[ai][bj][m][1] + b1;
            float v[8] = {v0[0], v0[1], v0[2], v0[3], v1[0], v1[1], v1[2], v1[3]};
#pragma unroll
            for (int j = 0; j < 8; ++j) {
                if (SUB == SUB_RELU2) { const float t = fmaxf(v[j], 0.f); v[j] = t * t; }
                else if (SUB == SUB_TANH) v[j] = 1.f - 2.f / (1.f + __expf(2.f * v[j]));
                else if (SUB == SUB_SIGM || SUB == SUB_SIGB) v[j] = sigmoidf_(v[j]);
                else if (SUB == SUB_EW) { const float x = -v[j]; const float sp = fmaxf(x, 0.f) + __logf(1.f + __expf(-fabsf(x))); v[j] = __expf(-sp - 0.5f); }
            }
            u32x4 pk; pk[0] = cvt_pk_bf16(v[0], v[1]); pk[1] = cvt_pk_bf16(v[2], v[3]); pk[2] = cvt_pk_bf16(v[4], v[5]); pk[3] = cvt_pk_bf16(v[6], v[7]);
            *(u32x4*)(dst0 + (size_t)(ai * 128 + m * 16) * ldc) = pk;
        }
}
template <int MODE> struct Epi {
    static constexpr bool PERM = true;
    bf16_t* O; int ldc; bf16_t* O2; const float* const* tbl;
    __device__ __forceinline__ void operator()(const f32x4 (&acc)[2][2][4][2], const pg8::Unit& u, int, int, int, int) const {
        const int t = opaque_tid(), lane = t & 63, wid = t >> 6, wr = wid >> 2, wc = wid & 3, fr = lane & 15, fq = lane >> 4;
        const size_t row0 = (size_t)(u.pm * 256 + wr * 64 + fr); const int col0 = u.pn * 256 + wc * 32 + 8 * fq;
        if (MODE == EPI_PLAIN) { epi_half<SUB_PLAIN>(acc, 0, O + row0 * ldc + col0, ldc, nullptr); epi_half<SUB_PLAIN>(acc, 1, O + row0 * ldc + col0 + 128, ldc, nullptr); }
        else if (MODE == EPI_RELU2) { epi_half<SUB_RELU2>(acc, 0, O + row0 * ldc + col0, ldc, nullptr); epi_half<SUB_RELU2>(acc, 1, O + row0 * ldc + col0 + 128, ldc, nullptr); }
        else if (MODE == EPI_LORA1) {
            if (u.pn == 0) { epi_half<SUB_TANH>(acc, 0, O + row0 * 384 + col0, 384, nullptr); epi_half<SUB_PLAIN>(acc, 1, O + row0 * 384 + col0 + 128, 384, nullptr); }
            else epi_half<SUB_SIGM>(acc, 0, O + row0 * 384 + col0, 384, nullptr);
        } else {
            const int seg = u.pn >> 3;
            if (seg == 0) { const float* p0 = tbl[31]; epi_half<SUB_EW>(acc, 0, O + row0 * 4096 + col0, 4096, p0 + col0); epi_half<SUB_EW>(acc, 1, O + row0 * 4096 + col0 + 128, 4096, p0 + col0 + 128); }
            else if (seg == 1) { const float* p1 = tbl[34]; epi_half<SUB_SIGB>(acc, 0, O + row0 * 4096 + col0, 4096, p1 + col0 - 2048); epi_half<SUB_SIGB>(acc, 1, O + row0 * 4096 + col0 + 128, 4096, p1 + col0 - 2048 + 128); }
            else { epi_half<SUB_PLAIN>(acc, 0, O2 + row0 * 1024 + col0 - 4096, 1024, nullptr); epi_half<SUB_PLAIN>(acc, 1, O2 + row0 * 1024 + col0 - 4096 + 128, 1024, nullptr); }
        }
    }
};
template <int MODE>
__device__ __forceinline__ void run_gemm(unsigned char* shm, const bf16_t* A, const bf16_t* Bt, int M, int N, int K, bf16_t* O, int ldc, bf16_t* O2 = nullptr, const float* const* tbl = nullptr, int lda = 0) {
    if (lda == 0) lda = K;
    asm volatile("" : "+s"(M), "+s"(N), "+s"(K), "+s"(lda));
    pg8::Gemm g{A, Bt, M, N, K, lda}; pg8::StaticOrder S; S.init(M, N, (int)gridDim.x, opaque_bid());
    Epi<MODE> E{O, ldc, O2, tbl};
    pg8::gemm_phase<Epi<MODE>, pg8::StaticOrder>((LAS unsigned char*)shm, g, S, E);
}

__device__ __forceinline__ void transpose_w(unsigned char* shm, const float* __restrict__ src, bf16_t* __restrict__ dst, int K, int N) {
    const int TIX = opaque_tid(); const int BIX = opaque_bid(); (void)TIX; (void)BIX;
    const int lane = TIX & 63, w = TIX >> 6;
    bf16_t* tl = (bf16_t*)(shm + w * 13312);
    const int ntn = N / 64, ntiles = (K / 64) * ntn;
    for (int tile = BIX * 8 + w; tile < ntiles; tile += gridDim.x * 8) {
        const int k0 = (tile / ntn) * 64, n0 = (tile % ntn) * 64;
        f32x4 v[16];
#pragma unroll
        for (int i = 0; i < 16; ++i) { const int kk = i * 4 + (lane >> 4), n4 = (lane & 15) * 4; v[i] = *(const f32x4*)(src + (size_t)(k0 + kk) * N + n0 + n4); }
#pragma unroll
        for (int i = 0; i < 16; ++i) { const int kk = i * 4 + (lane >> 4), n4 = (lane & 15) * 4;
            tl[(n4 + 0) * 72 + kk] = f2bf(v[i][0]); tl[(n4 + 1) * 72 + kk] = f2bf(v[i][1]); tl[(n4 + 2) * 72 + kk] = f2bf(v[i][2]); tl[(n4 + 3) * 72 + kk] = f2bf(v[i][3]); }
        WAVE_SYNC();
#pragma unroll
        for (int i = 0; i < 8; ++i) { const int n = i * 8 + (lane >> 3), k8 = (lane & 7) * 8;
            const u32x4 o = *(const u32x4*)(tl + n * 72 + k8);
            *(u32x4*)(dst + (size_t)(n0 + n) * K + k0 + k8) = o; }
        WAVE_SYNC();
    }
}

__device__ __forceinline__ void prologue(const Params& P, unsigned char* shm) {
    const int TIX = opaque_tid(); const int BIX = opaque_bid(); (void)TIX; (void)BIX;
    unsigned char* ws = P.ws;
    const int tid = TIX;
    const size_t gtid = (size_t)BIX * 512 + tid, gsz = (size_t)gridDim.x * 512;
    transpose_w(shm, P.in[10], (bf16_t*)(ws + WB_WINE), 2048, 4096);
    transpose_w(shm, P.in[11], (bf16_t*)(ws + WB_WINO), 2048, 6144);
    transpose_w(shm, P.in[12], (bf16_t*)(ws + WB_WOUT0), 2048, 2048);
    transpose_w(shm, P.in[12] + (size_t)2048 * 2048, (bf16_t*)(ws + WB_WOUT1), 2048, 2048);
    transpose_w(shm, P.in[13], (bf16_t*)(ws + WB_W1_0), 2048, 8192);
    transpose_w(shm, P.in[13] + (size_t)2048 * 8192, (bf16_t*)(ws + WB_W1_1), 2048, 8192);
    transpose_w(shm, P.in[14], (bf16_t*)(ws + WB_W2_0), 8192, 2048);
    transpose_w(shm, P.in[14] + (size_t)2048 * 8192, (bf16_t*)(ws + WB_W2_1), 8192, 2048);
    {   const float* mu = P.in[30]; const float* w1 = P.in[32]; const float* a1 = P.in[35]; const float* g1 = P.in[37];
        bf16_t* L1T = (bf16_t*)(ws + OFF_L1T);
        for (size_t i = gtid; i < (size_t)768 * 1024; i += gsz) {
            const int n = (int)(i >> 10), kk = (int)(i & 1023), nn = n < 384 ? n : n - 384; const bool hi = n >= 384;
            float sv = 0.f, m = 1.f;
            if (nn < 64) { sv = w1[(size_t)(kk) * 64 + nn]; m = mu[3 * 1024 + kk]; }
            else if (nn < 128) { sv = w1[(size_t)(1024 + kk) * 64 + (nn - 64)]; m = mu[3 * 1024 + kk]; }
            else if (nn < 192) { sv = a1[(size_t)(kk) * 64 + (nn - 128)]; m = mu[4 * 1024 + kk]; }
            else if (nn < 256) { sv = a1[(size_t)(1024 + kk) * 64 + (nn - 192)]; m = mu[4 * 1024 + kk]; }
            else { sv = g1[(size_t)kk * 128 + (nn - 256)]; m = mu[5 * 1024 + kk]; }
            L1T[i] = f2bf(hi ? m * sv : sv);
        }
        const float* w2 = P.in[33]; const float* a2 = P.in[36]; const float* g2 = P.in[38];
        bf16_t* L2T = (bf16_t*)(ws + OFF_L2T);
        for (size_t i = gtid; i < (size_t)5120 * 384; i += gsz) {
            const int n = (int)(i / 384), k = (int)(i % 384), seg = n >> 10, c = n & 1023;
            float s = 0.f;
            if (seg == 0 && k < 64) s = w2[(size_t)k * 1024 + c];
            else if (seg == 1 && k >= 64 && k < 128) s = w2[(size_t)(64 + k - 64) * 1024 + c];
            else if (seg == 2 && k >= 128 && k < 192) s = a2[(size_t)(k - 128) * 1024 + c];
            else if (seg == 3 && k >= 192 && k < 256) s = a2[(size_t)(64 + k - 192) * 1024 + c];
            else if (seg == 4 && k >= 256) s = g2[(size_t)(k - 256) * 1024 + c];
            L2T[i] = f2bf(s);
        }
        const float* sw = P.in[28]; bf16_t* WSB = (bf16_t*)(ws + OFF_WSB);
        for (size_t i = gtid; i < (size_t)8 * 128 * 128; i += gsz) WSB[i] = f2bf(sw[i]);
    }
    {   float* act = (float*)shm;
        float* red = (float*)(shm + 40960);
        __syncthreads();
        for (int i = tid; i < 5 * 2048; i += 512) { const int bi = i >> 11, k = i & 2047; const float c = bi < 4 ? P.in[1][bi * 2048 + k] : P.in[3][k]; act[i] = c / (1.f + __expf(-c)); }
        __syncthreads();
        float* MOD = (float*)(ws + OFF_MOD);
        const int kq = tid >> 6, col = tid & 63;
        for (int unit = BIX; unit < 2 * 192; unit += gridDim.x) {
            const int l = unit / 192, n0 = (unit % 192) * 64;
            const float* w = P.in[4] + (size_t)l * 2048 * 12288 + n0 + col;
            float a0 = 0.f, a1 = 0.f, a2 = 0.f, a3 = 0.f, a4 = 0.f;
#pragma unroll 8
            for (int k = kq * 256; k < kq * 256 + 256; ++k) { const float wv = w[(size_t)k * 12288];
                a0 += act[k] * wv; a1 += act[2048 + k] * wv; a2 += act[4096 + k] * wv; a3 += act[6144 + k] * wv; a4 += act[8192 + k] * wv; }
            red[(kq * 5 + 0) * 64 + col] = a0; red[(kq * 5 + 1) * 64 + col] = a1; red[(kq * 5 + 2) * 64 + col] = a2; red[(kq * 5 + 3) * 64 + col] = a3; red[(kq * 5 + 4) * 64 + col] = a4;
            __syncthreads();
            if (tid < 320) { const int bi = tid >> 6, cc = tid & 63; float s = P.in[5][l * 12288 + n0 + cc];
#pragma unroll
                for (int q = 0; q < 8; ++q) s += red[(q * 5 + bi) * 64 + cc];
                MOD[((size_t)l * 5 + bi) * 12288 + n0 + cc] = s; }
            __syncthreads();
        }
    }
}

__device__ __forceinline__ void resid_mod(const PP& P, int nrows, const float* xin_lat, const float* xin_ctx, float* xout_lat, float* xout_ctx,
                          const bf16_t* y, const float* gpost, int gate_off, int layer_g, int layer_m, const float* gpre, int sh_off, int sc_off, bf16_t* hn) {
    const int TIX = opaque_tid(); const int BIX = opaque_bid(); (void)TIX; (void)BIX;
    const float* MODG = (const float*)(P.ws + OFF_MOD) + (size_t)layer_g * 5 * 12288;
    const float* MODM = (const float*)(P.ws + OFF_MOD) + (size_t)layer_m * 5 * 12288;
    const int lane = TIX & 63, gw = BIX * 8 + (TIX >> 6), nw = gridDim.x * 8;
    for (int pr = gw; pr < nrows / 2; pr += nw) {
        const int row = 2 * pr;
        const bool isl = row < TL; const int bi = isl ? (row >> 13) : 4;
        const float* xi = isl ? xin_lat + (size_t)row * DM : xin_ctx + (size_t)(row - TL) * DM;
        const float* modg = MODG + (size_t)bi * 12288; const float* mod = MODM + (size_t)bi * 12288;
        f32x4 x[2][8];
#pragma unroll
        for (int q = 0; q < 2; ++q)
#pragma unroll
            for (int j = 0; j < 8; ++j) x[q][j] = *(const f32x4*)(xi + (size_t)q * DM + j * 256 + lane * 4);
        if (y) {
            u32x2 yr[2][8]; float ss0 = 0.f, ss1 = 0.f;
#pragma unroll
            for (int q = 0; q < 2; ++q)
#pragma unroll
                for (int j = 0; j < 8; ++j) yr[q][j] = *(const u32x2*)(y + (size_t)(row + q) * DM + j * 256 + lane * 4);
#pragma unroll
            for (int j = 0; j < 8; ++j) {
                const float a0 = bflo(yr[0][j][0]), a1 = bfhi(yr[0][j][0]), a2 = bflo(yr[0][j][1]), a3 = bfhi(yr[0][j][1]); ss0 += a0 * a0 + a1 * a1 + a2 * a2 + a3 * a3;
                const float b0 = bflo(yr[1][j][0]), b1 = bfhi(yr[1][j][0]), b2 = bflo(yr[1][j][1]), b3 = bfhi(yr[1][j][1]); ss1 += b0 * b0 + b1 * b1 + b2 * b2 + b3 * b3; }
            ss0 = wave_sum(ss0); ss1 = wave_sum(ss1);
            const float rs0 = rsqrtf(ss0 * (1.f / 2048.f) + 1e-6f), rs1 = rsqrtf(ss1 * (1.f / 2048.f) + 1e-6f);
#pragma unroll
            for (int j = 0; j < 8; ++j) { const int c = j * 256 + lane * 4; const f32x4 gp = *(const f32x4*)(gpost + c); const f32x4 gt = *(const f32x4*)(modg + gate_off + c);
                const f32x4 ggp = gt * gp;
                const f32x4 y0 = {bflo(yr[0][j][0]), bfhi(yr[0][j][0]), bflo(yr[0][j][1]), bfhi(yr[0][j][1])}, y1 = {bflo(yr[1][j][0]), bfhi(yr[1][j][0]), bflo(yr[1][j][1]), bfhi(yr[1][j][1])};
                x[0][j] += ggp * (y0 * rs0); x[1][j] += ggp * (y1 * rs1); }
        }
        if (xout_lat) { float* xo = isl ? xout_lat + (size_t)row * DM : xout_ctx + (size_t)(row - TL) * DM;
#pragma unroll
            for (int q = 0; q < 2; ++q)
#pragma unroll
                for (int j = 0; j < 8; ++j) *(f32x4*)(xo + (size_t)q * DM + j * 256 + lane * 4) = x[q][j]; }
        if (hn) {
            float ss0 = 0.f, ss1 = 0.f;
#pragma unroll
            for (int j = 0; j < 8; ++j) { ss0 += x[0][j][0] * x[0][j][0] + x[0][j][1] * x[0][j][1] + x[0][j][2] * x[0][j][2] + x[0][j][3] * x[0][j][3];
                ss1 += x[1][j][0] * x[1][j][0] + x[1][j][1] * x[1][j][1] + x[1][j][2] * x[1][j][2] + x[1][j][3] * x[1][j][3]; }
            ss0 = wave_sum(ss0); ss1 = wave_sum(ss1);
            const float rs0 = rsqrtf(ss0 * (1.f / 2048.f) + 1e-6f), rs1 = rsqrtf(ss1 * (1.f / 2048.f) + 1e-6f);
#pragma unroll
            for (int j = 0; j < 8; ++j) { const int c = j * 256 + lane * 4; const f32x4 g = *(const f32x4*)(gpre + c); const f32x4 sh = *(const f32x4*)(mod + sh_off + c); const f32x4 sc = *(const f32x4*)(mod + sc_off + c);
                const f32x4 gs = g * (sc + 1.f);
                const f32x4 h0 = (x[0][j] * rs0) * gs + sh, h1 = (x[1][j] * rs1) * gs + sh;
                u32x2 p0, p1; p0[0] = cvt_pk_bf16(h0[0], h0[1]); p0[1] = cvt_pk_bf16(h0[2], h0[3]); p1[0] = cvt_pk_bf16(h1[0], h1[1]); p1[1] = cvt_pk_bf16(h1[2], h1[3]);
                *(u32x2*)(hn + (size_t)row * DM + c) = p0; *(u32x2*)(hn + (size_t)(row + 1) * DM + c) = p1; }
        }
    }
}

template <bool FINAL>
__device__ __forceinline__ void s5_task(const PP& P, int task, unsigned char* wl, const bf16_t* z, float2* E, bf16_t* o) {
    const int TIX = opaque_tid(); const int BIX = opaque_bid(); (void)TIX; (void)BIX;
    const int lane = TIX & 63, fr = lane & 15, fq = lane >> 4;
    const int c = task % 132, bg = task / 132, g = bg & 63, b = bg >> 6;
    const bool isctx = c >= 128; const int t0 = isctx ? (c - 128) * 64 : c * 64;
    const size_t rowbase = isctx ? (size_t)TL + b * 256 + t0 : (size_t)b * 8192 + t0;
    float* buL = (float*)wl;
    bf16_t* xL = (bf16_t*)(wl + 8448);
    bf16_t* gL = (bf16_t*)wl;
    const float* a_re = P.in[15]; const float* a_im = P.in[16]; const float* log_dt = P.in[17];
    const float* b_re = P.in[18]; const float* b_im = P.in[19]; const float* c_re = P.in[20]; const float* c_im = P.in[21];
    f32x4 yacc[4];
    bf16x8 Uall[4];
#pragma unroll
    for (int i = 0; i < 4; ++i) { yacc[i] = (f32x4){0.f, 0.f, 0.f, 0.f}; Uall[i] = zero8(); if (fq < 2) Uall[i] = *(const bf16x8*)(z + (rowbase + i * 16 + fr) * 4096 + g * 16 + fq * 8); }
    if (FINAL) {
        float dv[8];
#pragma unroll
        for (int j = 0; j < 8; ++j) dv[j] = (fq < 2 && fq * 8 + j == fr) ? P.in[22][g * 16 + fr] : 0.f;
        const bf16x8 Dm = pack8(dv);
#pragma unroll
        for (int i = 0; i < 4; ++i) yacc[i] = MFMA16(Uall[i], Dm, yacc[i]);
    }
    for (int dir = 0; dir < 2; ++dir) {
        const int dg = dir * 64 + g;
        const float dt = __expf(log_dt[dg]);
        float lre, lim;
        lam_bar_of(a_re[dg * 64 + lane], a_im[dg * 64 + lane], dt, lre, lim);
        bf16x8 Bm[8];
#pragma unroll
        for (int q = 0; q < 4; ++q) {
            const int n = q * 16 + fr;
            const float are = a_re[dg * 64 + n], aim = a_im[dg * 64 + n]; float l_re, l_im; lam_bar_of(are, aim, dt, l_re, l_im);
            const float nr = l_re - 1.f, ni = l_im, den = 1.f / (are * are + aim * aim);
            const float cre = (nr * are + ni * aim) * den, cim = (ni * are - nr * aim) * den;
            if (fq < 2) {
                const float* pr = b_re + ((size_t)dg * 64 + n) * 16 + fq * 8; const float* pi = b_im + ((size_t)dg * 64 + n) * 16 + fq * 8;
                const f32x4 r0 = *(const f32x4*)pr, r1 = *(const f32x4*)(pr + 4), i0 = *(const f32x4*)pi, i1 = *(const f32x4*)(pi + 4);
                Bm[q] = pack8v(r0 * cre - i0 * cim, r1 * cre - i1 * cim);
                Bm[q + 4] = pack8v(i0 * cre + r0 * cim, i1 * cre + r1 * cim);
            } else { Bm[q] = zero8(); Bm[q + 4] = zero8(); }
        }
        bf16x8 Cm[4];
        if (FINAL) {
#pragma unroll
            for (int kk = 0; kk < 4; ++kk) {
                const int k = kk * 32 + fq * 8;
                if (k < 64) { const float* pc = c_re + ((size_t)dg * 16 + fr) * 64 + k; Cm[kk] = pack8v(*(const f32x4*)pc, *(const f32x4*)(pc + 4)); }
                else { const float* pc = c_im + ((size_t)dg * 16 + fr) * 64 + (k - 64); Cm[kk] = pack8v(-*(const f32x4*)pc, -*(const f32x4*)(pc + 4)); }
            }
        }
        const int ci = dir == 0 ? (isctx ? (c - 128) : 4 + c) : (isctx ? 3 - (c - 128) : 4 + (127 - c));
        const size_t eidx = ((((size_t)dir * 4 + b) * 64 + g) * 132 + ci) * 64 + lane;
        float xr = 0.f, xi = 0.f;
        if (FINAL) { const float2 e = E[eidx]; xr = e.x; xi = e.y; }
#pragma unroll
        for (int mi = 0; mi < 4; ++mi) {
            const int mt = dir == 0 ? mi : 3 - mi;
            const bf16x8 Ua = dir == 0 ? Uall[mi] : Uall[3 - mi];
#pragma unroll
            for (int nt = 0; nt < 8; ++nt) {
                f32x4 d = {0.f, 0.f, 0.f, 0.f};
                asm volatile("" : "+v"(d));
                d = MFMA16(Ua, Bm[nt], d);
                asm volatile("" :: "v"(Ua));
#pragma unroll
                for (int i = 0; i < 4; ++i) buL[(fq * 4 + i) * 132 + nt * 16 + fr] = d[i];
            }
            WAVE_SYNC();
#pragma unroll
            for (int s = 0; s < 16; ++s) {
                const int tl = dir == 0 ? s : 15 - s;
                const float br = buL[tl * 132 + lane], bi = buL[tl * 132 + 64 + lane];
                const float nr = lre * xr - lim * xi + br, ni = lre * xi + lim * xr + bi; xr = nr; xi = ni;
                if (FINAL) { xL[tl * 144 + lane] = f2bf(xr); xL[tl * 144 + 64 + lane] = f2bf(xi); }
            }
            WAVE_SYNC();
            if (FINAL) {
                f32x4 ya = dir == 0 ? yacc[mi] : yacc[3 - mi];
#pragma unroll
                for (int kk = 0; kk < 4; ++kk) { const bf16x8 Xa = *(const bf16x8*)(xL + fr * 144 + kk * 32 + fq * 8); ya = MFMA16(Xa, Cm[kk], ya); }
                if (dir == 0) yacc[mi] = ya; else yacc[3 - mi] = ya;
                WAVE_SYNC();
            }
        }
        if (!FINAL) E[eidx] = make_float2(xr, xi);
    }
    if (FINAL) {
        const float* glw = P.in[23]; const float* glb = P.in[24];
#pragma unroll
        for (int mt = 0; mt < 4; ++mt)
#pragma unroll
            for (int i = 0; i < 4; ++i) { const int t = mt * 16 + fq * 4 + i;
                gL[t * 32 + fr] = f2bf(gelu_tanh(yacc[mt][i])); }
        WAVE_SYNC();
        bf16x8 Wv = zero8(), Wg = zero8();
        if (fq < 2) { float wv[8], wg[8];
#pragma unroll
            for (int j = 0; j < 8; ++j) { const int p = fq * 8 + j; wv[j] = glw[((size_t)g * 16 + p) * 16 + fr]; wg[j] = glw[((size_t)(64 + g) * 16 + p) * 16 + fr]; }
            Wv = pack8(wv); Wg = pack8(wg); }
        const float bv = glb[g * 16 + fr], bgt = glb[(64 + g) * 16 + fr];
#pragma unroll
        for (int mt = 0; mt < 4; ++mt) {
            bf16x8 Ga = zero8();
            if (fq < 2) Ga = *(const bf16x8*)(gL + (mt * 16 + fr) * 32 + fq * 8);
            f32x4 val = {0.f, 0.f, 0.f, 0.f}, gt = {0.f, 0.f, 0.f, 0.f};
            asm volatile("" : "+v"(val), "+v"(gt));
            val = MFMA16(Ga, Wv, val); gt = MFMA16(Ga, Wg, gt);
            asm volatile("" :: "v"(Ga));
#pragma unroll
            for (int i = 0; i < 4; ++i) { const int t = mt * 16 + fq * 4 + i;
                o[(rowbase + t) * 2048 + g * 16 + fr] = f2bf((val[i] + bv) * sigmoidf_(gt[i] + bgt)); }
        }
        WAVE_SYNC();
    }
}

__device__ __forceinline__ void s5_carry(const PP& P, float2* E) {
    const int TIX = opaque_tid(); const int BIX = opaque_bid(); (void)TIX; (void)BIX;
    const int gt = BIX * 512 + TIX;
    if (gt >= 2 * 4 * 64 * 64) return;
    const int n = gt & 63, g = (gt >> 6) & 63, b = (gt >> 12) & 3, dir = gt >> 14;
    const int dg = dir * 64 + g;
    const float dt = __expf(P.in[17][dg]);
    float pr, pi; lam_bar_of(P.in[15][dg * 64 + n], P.in[16][dg * 64 + n], dt, pr, pi);
#pragma unroll
    for (int i = 0; i < 6; ++i) { const float r = pr * pr - pi * pi, im = 2.f * pr * pi; pr = r; pi = im; }
    float sr = 0.f, si = 0.f;
    float2* e = E + ((((size_t)dir * 4 + b) * 64 + g) * 132) * 64 + n;
    for (int ci = 0; ci < 132; ++ci) { const float2 v = e[(size_t)ci * 64]; e[(size_t)ci * 64] = make_float2(sr, si);
        const float nr = pr * sr - pi * si + v.x, ni = pr * si + pi * sr + v.y; sr = nr; si = ni; }
}

__device__ __forceinline__ void vt_task(int task, unsigned char* wl, const bf16_t* z, bf16_t* VT, bf16_t* VCT) {
    const int TIX = opaque_tid(); const int BIX = opaque_bid(); (void)TIX; (void)BIX;
    const int lane = TIX & 63, tile = task >> 4, h = task & 15; const size_t row0 = (size_t)tile * 64;
    bf16_t* tl = (bf16_t*)wl;
#pragma unroll
    for (int i = 0; i < 8; ++i) { const int tok = i * 8 + (lane >> 3), d0 = (lane & 7) * 8;
        const u32x4 v = *(const u32x4*)(z + (row0 + tok) * 4096 + 3072 + h * 64 + d0);
#pragma unroll
        for (int j = 0; j < 4; ++j) { tl[(d0 + 2 * j) * 72 + tok] = (bf16_t)(v[j] & 0xffffu); tl[(d0 + 2 * j + 1) * 72 + tok] = (bf16_t)(v[j] >> 16); } }
    WAVE_SYNC();
    bf16_t* base; int ld;
    if (row0 < (size_t)TL) { const int b = (int)(row0 >> 13), tok0 = (int)(row0 & 8191); base = VT + ((size_t)(b * 16 + h) * 64) * 8192 + tok0; ld = 8192; }
    else { const int rr = (int)(row0 - TL), b = rr >> 8, tok0 = rr & 255; base = VCT + ((size_t)(b * 16 + h) * 64) * 256 + tok0; ld = 256; }
#pragma unroll
    for (int i = 0; i < 8; ++i) { const int d = i * 8 + (lane >> 3), t8 = (lane & 7) * 8;
        const u32x4 v = *(const u32x4*)(tl + d * 72 + t8); *(u32x4*)(base + (size_t)d * ld + t8) = v; }
    WAVE_SYNC();
}

template <bool BAND>
__device__ __forceinline__ void attn_task(const PP& P, int task, unsigned char* wl, const bf16_t* z, const bf16_t* VT, const bf16_t* VCT, bf16_t* o, const bf16_t* KL = nullptr, const bf16_t* VL = nullptr) {
    const int TIX = opaque_tid(); const int BIX = opaque_bid(); (void)TIX; (void)BIX;
    const int lane = TIX & 63, fr = lane & 15, fq = lane >> 4;
    int b, h, r = 0, qt; size_t qrow0;
    if (BAND) { qt = task & 3; r = (task >> 2) & 127; h = (task >> 9) & 15; b = task >> 13; qrow0 = (size_t)b * 8192 + r * 64 + qt * 16; }
    else { qt = task & 15; h = (task >> 4) & 15; b = task >> 8; qrow0 = (size_t)TL + b * 256 + qt * 16; }
    const int start = min(max(r - 4, 0), 120), wsq = min(max(qt * 16 - 8, 0), 32);
    bf16_t* pL = (bf16_t*)wl;
    const float* rpb = P.in[25];
    bf16x8 Qa[2];
    Qa[0] = *(const bf16x8*)(z + (qrow0 + fr) * 4096 + 1024 + h * 64 + fq * 8);
    Qa[1] = *(const bf16x8*)(z + (qrow0 + fr) * 4096 + 1024 + h * 64 + 32 + fq * 8);
    constexpr int NP0 = BAND ? 0 : 4;
    float mx[4] = {-1e30f, -1e30f, -1e30f, -1e30f}, ls[4] = {0.f, 0.f, 0.f, 0.f};
    f32x4 O[4];
#pragma unroll
    for (int i = 0; i < 4; ++i) O[i] = (f32x4){0.f, 0.f, 0.f, 0.f};
    bf16x8 Kc[4][2];
#define ATT_LOADK(dst, pc) do { _Pragma("unroll") for (int ntl = 0; ntl < 4; ++ntl) { const int nt_ = (pc) * 4 + ntl; size_t krow_; \
        if ((pc) < 4) krow_ = (size_t)b * 8192 + (start + (nt_ >> 1)) * 64 + wsq + (nt_ & 1) * 16 + fr; else krow_ = (size_t)TL + b * 256 + (nt_ - 16) * 16 + fr; \
        const bf16_t* kp_ = ((pc) >= 4 && KL) ? KL + ((nt_ - 16) * 16 + fr) * 72 + fq * 8 : z + krow_ * 4096 + 2048 + h * 64 + fq * 8; dst[ntl][0] = *(const bf16x8*)kp_; dst[ntl][1] = *(const bf16x8*)(kp_ + 32); } } while (0)
    ATT_LOADK(Kc, NP0);
#pragma unroll 1
    for (int piece = NP0; piece < 8; ++piece) {
        const bool band = piece < 4;
        bf16x8 Vc[2][4];
#pragma unroll
        for (int kk = 0; kk < 2; ++kk) {
            const int kg = piece * 2 + kk;
#pragma unroll
            for (int dt = 0; dt < 4; ++dt) {
                const int d = dt * 16 + fr; const bf16_t* vp;
                if (band) vp = VT + ((size_t)(b * 16 + h) * 64 + d) * 8192 + (start + kg) * 64 + wsq + fq * 8;
                else if (VL) vp = VL + d * 264 + (kg - 8) * 32 + fq * 8;
                else vp = VCT + ((size_t)(b * 16 + h) * 64 + d) * 256 + (kg - 8) * 32 + fq * 8;
                Vc[kk][dt] = *(const bf16x8*)vp;
            }
        }
        float bias[4][4];
#pragma unroll
        for (int ntl = 0; ntl < 4; ++ntl)
#pragma unroll
            for (int i = 0; i < 4; ++i) {
                bias[ntl][i] = 0.f;
                if (BAND && band) {
                    const int nt = piece * 4 + ntl;
                    const int kcol = wsq + (nt & 1) * 16 + fr, qcol = qt * 16 + fq * 4 + i;
                    const int dr = start + (nt >> 1) - r + 7, dc = min(max(kcol - qcol + 15, 0), 30);
                    bias[ntl][i] = rpb[(h * 15 + dr) * 31 + dc];
                }
            }
        bf16x8 Kn[4][2];
#pragma unroll
        for (int ntl = 0; ntl < 4; ++ntl) { Kn[ntl][0] = Kc[ntl][0]; Kn[ntl][1] = Kc[ntl][1]; }
        if (piece + 1 < 8) ATT_LOADK(Kn, piece + 1);
        f32x4 S[4];
#pragma unroll
        for (int ntl = 0; ntl < 4; ++ntl) {
            f32x4 sacc = {0.f, 0.f, 0.f, 0.f};
            asm volatile("" : "+v"(sacc));
            sacc = MFMA16(Qa[0], Kc[ntl][0], sacc);
            sacc = MFMA16(Qa[1], Kc[ntl][1], sacc);
            S[ntl] = sacc;
        }
        if (BAND) asm volatile("" : "+v"(bias[0][0]), "+v"(bias[0][1]), "+v"(bias[0][2]), "+v"(bias[0][3]), "+v"(bias[1][0]), "+v"(bias[1][1]), "+v"(bias[1][2]), "+v"(bias[1][3]),
                                    "+v"(bias[2][0]), "+v"(bias[2][1]), "+v"(bias[2][2]), "+v"(bias[2][3]), "+v"(bias[3][0]), "+v"(bias[3][1]), "+v"(bias[3][2]), "+v"(bias[3][3]));
        float ml[4] = {-1e30f, -1e30f, -1e30f, -1e30f};
#pragma unroll
        for (int ntl = 0; ntl < 4; ++ntl)
#pragma unroll
            for (int i = 0; i < 4; ++i) {
                float sc = S[ntl][i] * 0.125f;
                if (BAND && band) {
                    const int nt = piece * 4 + ntl;
                    const int kcol = wsq + (nt & 1) * 16 + fr, qcol = qt * 16 + fq * 4 + i, cs = min(max(qcol - 8, 0), 48);
                    const bool valid = (kcol >= cs) && (kcol < cs + 16);
                    sc = valid ? sc + bias[ntl][i] : -1e30f;
                }
                S[ntl][i] = sc; ml[i] = fmaxf(ml[i], sc);
            }
        float al[4];
#pragma unroll
        for (int i = 0; i < 4; ++i) { const float mn = fmaxf(mx[i], max16(ml[i])); al[i] = __expf(mx[i] - mn); mx[i] = mn; ls[i] *= al[i]; }
#pragma unroll
        for (int ntl = 0; ntl < 4; ++ntl)
#pragma unroll
            for (int i = 0; i < 4; ++i) { const float p = __expf(S[ntl][i] - mx[i]); ls[i] += p; pL[(fq * 4 + i) * 80 + ntl * 16 + fr] = f2bf(p); }
#pragma unroll
        for (int dt = 0; dt < 4; ++dt)
#pragma unroll
            for (int i = 0; i < 4; ++i) O[dt][i] *= al[i];
        WAVE_SYNC();
#pragma unroll
        for (int kk = 0; kk < 2; ++kk) {
            const bf16x8 Pa = *(const bf16x8*)(pL + fr * 80 + kk * 32 + fq * 8);
#pragma unroll
            for (int dt = 0; dt < 4; ++dt) O[dt] = MFMA16(Pa, Vc[kk][dt], O[dt]);
        }
        WAVE_SYNC();
#pragma unroll
        for (int ntl = 0; ntl < 4; ++ntl) { Kc[ntl][0] = Kn[ntl][0]; Kc[ntl][1] = Kn[ntl][1]; }
    }
#undef ATT_LOADK
    float sm[4];
#pragma unroll
    for (int i = 0; i < 4; ++i) sm[i] = 1.f / sum16(ls[i]);
#pragma unroll
    for (int dt = 0; dt < 4; ++dt)
#pragma unroll
        for (int i = 0; i < 4; ++i) o[(qrow0 + fq * 4 + i) * 2048 + 1024 + h * 64 + dt * 16 + fr] = f2bf(O[dt][i] * sm[i]);
}


__device__ __forceinline__ void attn_naive(const PP& P, int task, unsigned char* wl, const bf16_t* z, bf16_t* o, bool band) {
    const int lane = opaque_tid() & 63;
    float* pbuf = (float*)wl; int* kbuf = (int*)(wl + 2048);
    int b, h, r = 0, col; size_t qrow;
    if (band) { h = task & 15; const int tok = (task >> 4) & 8191; b = task >> 17; r = tok >> 6; col = tok & 63; qrow = (size_t)b * 8192 + tok; }
    else { h = task & 15; col = (task >> 4) & 255; b = task >> 12; qrow = (size_t)TL + b * 256 + col; }
    const int start = min(max(r - 4, 0), 120), cs = min(max(col - 8, 0), 48);
    float q[64];
#pragma unroll
    for (int e = 0; e < 64; e += 2) { const unsigned u = *(const unsigned*)(z + qrow * 4096 + 1024 + h * 64 + e); q[e] = bflo(u) * 0.125f; q[e + 1] = bfhi(u) * 0.125f; }
    float sc[6]; int kr[6]; float m = -1e30f;
#pragma unroll
    for (int kk = 0; kk < 6; ++kk) {
        float bias = 0.f; bool valid = true; size_t krow;
        if (kk < 2) { const int kidx = kk * 64 + lane, jr = kidx >> 4, jc = kidx & 15; krow = (size_t)b * 8192 + (start + jr) * 64 + cs + jc;
            const int bi = band ? (h * 15 + start + jr - r + 7) * 31 + (cs + jc - col + 15) : 0; bias = P.in[25][bi]; valid = band; }
        else krow = (size_t)TL + b * 256 + (kk - 2) * 64 + lane;
        float d = 0.f;
#pragma unroll
        for (int e = 0; e < 64; e += 8) { const u32x4 u = *(const u32x4*)(z + krow * 4096 + 2048 + h * 64 + e);
            d += q[e] * bflo(u[0]) + q[e + 1] * bfhi(u[0]) + q[e + 2] * bflo(u[1]) + q[e + 3] * bfhi(u[1]) + q[e + 4] * bflo(u[2]) + q[e + 5] * bfhi(u[2]) + q[e + 6] * bflo(u[3]) + q[e + 7] * bfhi(u[3]); }
        sc[kk] = valid ? d + bias : -1e30f; kr[kk] = (int)krow; m = fmaxf(m, sc[kk]);
    }
#pragma unroll
    for (int o2 = 32; o2 > 0; o2 >>= 1) m = fmaxf(m, __shfl_xor(m, o2));
    float l = 0.f;
#pragma unroll
    for (int kk = 0; kk < 6; ++kk) { const float p = __expf(sc[kk] - m); l += p; pbuf[kk * 64 + lane] = p; kbuf[kk * 64 + lane] = kr[kk]; }
    l = wave_sum(l);
    WAVE_SYNC();
    float acc = 0.f;
    for (int i = band ? 0 : 128; i < 384; ++i) acc += pbuf[i] * bf2f(z[(size_t)kbuf[i] * 4096 + 3072 + h * 64 + lane]);
    o[qrow * 2048 + 1024 + h * 64 + lane] = f2bf(acc / l);
    WAVE_SYNC();
}

__device__ __forceinline__ void sgu_pre(const PP& P, unsigned char* shm, const bf16_t* z, bf16_t* VLNT) {
    const int TIX = opaque_tid(); const int BIX = opaque_bid(); (void)TIX; (void)BIX;
    bf16_t* tl = (bf16_t*)shm;
    const int tid = TIX, lane = tid & 63, w = tid >> 6;
    const float* lg = P.in[26]; const float* lb = P.in[27];
    for (int bt = BIX; bt < TL / 32; bt += gridDim.x) {
        const size_t row0 = (size_t)bt * 32;
        for (int tk = 0; tk < 4; ++tk) {
            const int tokl = w * 4 + tk; const size_t row = row0 + tokl;
            float v[16]; float s = 0.f;
#pragma unroll
            for (int j = 0; j < 4; ++j) { const u32x2 r = *(const u32x2*)(z + row * 6144 + 1024 + j * 256 + lane * 4);
                v[j * 4 + 0] = gelu_tanh(bflo(r[0])); v[j * 4 + 1] = gelu_tanh(bfhi(r[0])); v[j * 4 + 2] = gelu_tanh(bflo(r[1])); v[j * 4 + 3] = gelu_tanh(bfhi(r[1]));
                s += v[j * 4] + v[j * 4 + 1] + v[j * 4 + 2] + v[j * 4 + 3]; }
            const float mean = wave_sum(s) * (1.f / 1024.f);
            float q = 0.f;
#pragma unroll
            for (int j = 0; j < 16; ++j) { v[j] -= mean; q += v[j] * v[j]; }
            const float rstd = rsqrtf(wave_sum(q) * (1.f / 1024.f) + 1e-5f);
#pragma unroll
            for (int j = 0; j < 4; ++j)
#pragma unroll
                for (int e = 0; e < 4; ++e) { const int ch = j * 256 + lane * 4 + e; tl[ch * 40 + tokl] = f2bf(v[j * 4 + e] * rstd * lg[ch] + lb[ch]); }
        }
        __syncthreads();
        const int b = (int)(row0 >> 13), tok0 = (int)(row0 & 8191);
#pragma unroll
        for (int i = 0; i < 8; ++i) { const int idx = i * 512 + tid, ch = idx >> 2, t8 = (idx & 3) * 8;
            const u32x4 vv = *(const u32x4*)(tl + ch * 40 + t8);
            *(u32x4*)(VLNT + ((size_t)b * 1024 + ch) * 8192 + tok0 + t8) = vv; }
        __syncthreads();
    }
}
__device__ __forceinline__ void sgu_task(const PP& P, int task, const bf16_t* z, const bf16_t* VLNT, const bf16_t* WSB, bf16_t* o) {
    const int TIX = opaque_tid(); const int BIX = opaque_bid(); (void)TIX; (void)BIX;
    const int lane = TIX & 63, fr = lane & 15, fq = lane >> 4;
    const int pq = task & 3, h = (task >> 2) & 7, n = (task >> 5) & 63, b = task >> 11;
    f32x4 acc[2][8];
#pragma unroll
    for (int m = 0; m < 2; ++m)
#pragma unroll
        for (int ct = 0; ct < 8; ++ct) acc[m][ct] = (f32x4){0.f, 0.f, 0.f, 0.f};
#pragma unroll
    for (int kk = 0; kk < 4; ++kk) {
        bf16x8 Aw[2];
#pragma unroll
        for (int m = 0; m < 2; ++m) Aw[m] = *(const bf16x8*)(WSB + ((size_t)h * 128 + pq * 32 + m * 16 + fr) * 128 + kk * 32 + fq * 8);
#pragma unroll
        for (int ct = 0; ct < 8; ++ct) {
            const bf16x8 Bv = *(const bf16x8*)(VLNT + ((size_t)b * 1024 + h * 128 + ct * 16 + fr) * 8192 + n * 128 + kk * 32 + fq * 8);
            acc[0][ct] = MFMA16(Aw[0], Bv, acc[0][ct]); acc[1][ct] = MFMA16(Aw[1], Bv, acc[1][ct]);
        }
    }
    const float* sb = P.in[29];
#pragma unroll
    for (int m = 0; m < 2; ++m)
#pragma unroll
        for (int i = 0; i < 4; ++i) {
            const int p = pq * 32 + m * 16 + fq * 4 + i; const float bias = sb[h * 128 + p];
            const size_t row = (size_t)b * 8192 + n * 128 + p;
#pragma unroll
            for (int ct = 0; ct < 8; ++ct) { const int c = h * 128 + ct * 16 + fr;
                const float u = gelu_tanh(bf2f(z[row * 6144 + c]));
                o[row * 2048 + c] = f2bf(u * (acc[m][ct][i] + bias)); }
        }
}

__device__ __forceinline__ void lora1_combine(const bf16_t* U, bf16_t* L1) {
    const int TIX = opaque_tid(); const int BIX = opaque_bid(); (void)TIX; (void)BIX;
    const size_t gtid = (size_t)BIX * 512 + TIX, gsz = (size_t)gridDim.x * 512;
    for (size_t i = gtid; i < (size_t)TT * 48; i += gsz) {
        const size_t row = i / 48; const int c = (int)(i % 48) * 8;
        int t, L; if (row < (size_t)TL) { t = (int)(row & 8191); L = 8192; } else { t = (int)((row - TL) & 255); L = 256; }
        const bf16_t* p = U + row * 768 + c;
        const u32x4 base = *(const u32x4*)p, cur = *(const u32x4*)(p + 384);
        u32x4 pv = {0u, 0u, 0u, 0u}, nx = {0u, 0u, 0u, 0u};
        if (t > 0) pv = *(const u32x4*)(p + 384 - 768);
        if (t < L - 1) nx = *(const u32x4*)(p + 384 + 768);
        u32x4 d;
#pragma unroll
        for (int j = 0; j < 4; ++j) {
            float lo = bflo(base[j]) + 0.5f * (bflo(pv[j]) + bflo(nx[j])) - bflo(cur[j]), hi = bfhi(base[j]) + 0.5f * (bfhi(pv[j]) + bfhi(nx[j])) - bfhi(cur[j]);
            if (c < 128) { lo = 1.f - 2.f / (1.f + __expf(2.f * lo)); hi = 1.f - 2.f / (1.f + __expf(2.f * hi)); }
            else if (c >= 256) { lo = sigmoidf_(lo); hi = sigmoidf_(hi); }
            d[j] = cvt_pk_bf16(lo, hi);
        }
        *(u32x4*)(L1 + row * 384 + c) = d;
    }
}

struct RwRaw { u32x2 r[3], k[3], v[3], ew, a; };
__device__ __forceinline__ void rw_rowinfo(int dir, int b, int gs, size_t& row, bool& hasp, bool& hasn, bool& islat) {
    if (gs < 256) { const int t = dir == 0 ? gs : 255 - gs; row = (size_t)TL + b * 256 + t; hasp = t > 0; hasn = t < 255; islat = false; }
    else { const int t = dir == 0 ? gs - 256 : 8191 - (gs - 256); row = (size_t)b * 8192 + t; hasp = t > 0; hasn = t < 8191; islat = true; }
}
__device__ __forceinline__ void rw_loadA(RwRaw& R, const bf16_t* z, const bf16_t* EWA, int dir, int b, int h, int gs, int cq) {
    size_t row; bool hp, hn, il; rw_rowinfo(dir, b, gs, row, hp, hn, il);
    const bf16_t* p = z + row * 6144 + 2048 + h * 64 + cq * 4;
    const u32x2 zz = {0u, 0u};
    R.r[1] = *(const u32x2*)p; R.k[1] = *(const u32x2*)(p + 1024); R.v[1] = *(const u32x2*)(p + 2048);
    R.r[0] = hp ? *(const u32x2*)(p - 6144) : zz; R.k[0] = hp ? *(const u32x2*)(p - 6144 + 1024) : zz; R.v[0] = hp ? *(const u32x2*)(p - 6144 + 2048) : zz;
    R.r[2] = hn ? *(const u32x2*)(p + 6144) : zz; R.k[2] = hn ? *(const u32x2*)(p + 6144 + 1024) : zz; R.v[2] = hn ? *(const u32x2*)(p + 6144 + 2048) : zz;
    const bf16_t* e = EWA + row * 4096 + dir * 1024 + h * 64 + cq * 4;
    R.ew = *(const u32x2*)e; R.a = *(const u32x2*)(e + 2048);
}
__device__ __forceinline__ void un4(const u32x2 u, float* f) { f[0] = bflo(u[0]); f[1] = bfhi(u[0]); f[2] = bflo(u[1]); f[3] = bfhi(u[1]); }
constexpr int RW_BUF = 49664;
__device__ __forceinline__ void rw_stageB(const RwRaw& R, float* buf, int s_ld, int cq, int dir, int b, int h, int rh, int gs, float* BONUS,
                                          const float (&mu0)[4], const float (&mu1)[4], const float (&mu2)[4], const float (&kk_)[4], const float (&ka_)[4], const float (&rk_)[4]) {
    size_t row; bool hp, hn, il; rw_rowinfo(dir, b, gs, row, hp, hn, il);
    float rp[4], rc[4], rn[4], kp[4], kc[4], kn[4], vp[4], vc[4], vn[4], ew[4], aa[4];
    un4(R.r[0], rp); un4(R.r[1], rc); un4(R.r[2], rn); un4(R.k[0], kp); un4(R.k[1], kc); un4(R.k[2], kn); un4(R.v[0], vp); un4(R.v[1], vc); un4(R.v[2], vn); un4(R.ew, ew); un4(R.a, aa);
    f32x4 wv, kkv, kav, kdv, wrv, vv; float n2 = 0.f, bon = 0.f, cc = 0.f; float kr[4], rr[4];
#pragma unroll
    for (int e = 0; e < 4; ++e) {
        const float r_ = rc[e] + mu0[e] * (0.5f * (rp[e] + rn[e]) - rc[e]);
        const float k_ = kc[e] + mu1[e] * (0.5f * (kp[e] + kn[e]) - kc[e]);
        const float v_ = vc[e] + mu2[e] * (0.5f * (vp[e] + vn[e]) - vc[e]);
        kr[e] = k_ * kk_[e]; n2 += kr[e] * kr[e];
        const float kd = k_ * (1.f + (aa[e] - 1.f) * ka_[e]);
        wv[e] = __expf(-ew[e]); kdv[e] = kd; rr[e] = r_; wrv[e] = wv[e] * r_; vv[e] = v_; bon += r_ * kd * rk_[e]; cc += kd * r_;
    }
    n2 = sum16(n2); bon = sum16(bon);
    const float inv = 1.f / fmaxf(sqrtf(n2), 1e-12f);
    float bb = 0.f;
#pragma unroll
    for (int e = 0; e < 4; ++e) { kkv[e] = kr[e] * inv; kav[e] = kkv[e] * aa[e]; bb += kav[e] * rr[e]; }
    bb = sum16(bb); cc = sum16(cc);
    float* bs = buf + s_ld * 64 + cq * 4;
    *(f32x4*)bs = wv; *(f32x4*)(bs + 2048) = kkv; *(f32x4*)(bs + 4096) = kav; *(f32x4*)(bs + 6144) = kdv; *(f32x4*)(bs + 8192) = wrv; *(f32x4*)(bs + 10240) = vv;
    if (cq == 0) { buf[12288 + 2 * s_ld] = bb; buf[12289 + 2 * s_ld] = cc; }
    if (il && rh == 0 && cq == 0) BONUS[(row * 16 + h) * 2 + dir] = bon;
}
__device__ __forceinline__ void rwkv_scan(const PP& P, unsigned char* shm, const bf16_t* zc, bf16_t* z, const bf16_t* EWA, float* BONUS) {
    const int TIX = opaque_tid(); const int BIX = opaque_bid(); (void)TIX; (void)BIX;
    const int tid = TIX, lane = tid & 63, w = __builtin_amdgcn_readfirstlane(tid >> 6);
    const float* mu = P.in[30]; const float* k_k = P.in[39]; const float* k_a = P.in[40]; const float* r_k = P.in[41];
    for (int task = BIX; task < 256; task += gridDim.x) {
        const int rh = task & 1, dir = (task >> 1) & 1, h = (task >> 2) & 15, b = task >> 6;
        __syncthreads();
        if (w >= 4) {
            const int lt = tid - 256, s0 = lt >> 4, cq = lt & 15, hc = h * 64 + cq * 4;
            float mu0[4], mu1[4], mu2[4], kk_[4], ka_[4], rk_[4];
#pragma unroll
            for (int e = 0; e < 4; ++e) { mu0[e] = mu[hc + e]; mu1[e] = mu[1024 + hc + e]; mu2[e] = mu[2048 + hc + e]; kk_[e] = k_k[hc + e]; ka_[e] = k_a[hc + e]; rk_[e] = r_k[hc + e]; }
            RwRaw R0, R1;
            rw_loadA(R0, zc, EWA, dir, b, h, s0, cq); rw_loadA(R1, zc, EWA, dir, b, h, s0 + 16, cq);
            for (int ci = -1; ci < 264; ++ci) {
                if (ci + 1 < 264) {
                    float* buf = (float*)(shm + ((ci + 1) & 1) * RW_BUF);
                    rw_stageB(R0, buf, s0, cq, dir, b, h, rh, (ci + 1) * 32 + s0, BONUS, mu0, mu1, mu2, kk_, ka_, rk_);
                    rw_stageB(R1, buf, s0 + 16, cq, dir, b, h, rh, (ci + 1) * 32 + s0 + 16, BONUS, mu0, mu1, mu2, kk_, ka_, rk_);
                    if (ci + 2 < 264) { rw_loadA(R0, zc, EWA, dir, b, h, (ci + 2) * 32 + s0, cq); rw_loadA(R1, zc, EWA, dir, b, h, (ci + 2) * 32 + s0 + 16, cq); }
                }
                __syncthreads();
            }
        } else {
            const int rp = lane >> 4, cs = lane & 15, vrow0 = rh * 32 + w * 8 + rp * 2;
            f32x2_t Sp[4];
#pragma unroll
            for (int j = 0; j < 4; ++j) Sp[j] = (f32x2_t){0.f, 0.f};
            for (int ci = -1; ci < 264; ++ci) {
                if (ci >= 0) {
                    const float* buf = (const float*)(shm + (ci & 1) * RW_BUF);
                    const bool islat = ci >= 8;
                    const float* bq = buf + cs * 4;
                    f32x4 w4 = *(const f32x4*)bq, kk4 = *(const f32x4*)(bq + 2048), ka4 = *(const f32x4*)(bq + 4096), kd4 = *(const f32x4*)(bq + 6144), wr4 = *(const f32x4*)(bq + 8192);
                    f32x2_t v2 = *(const f32x2_t*)(buf + 10240 + vrow0), bc = *(const f32x2_t*)(buf + 12288);
                    float yk0 = 0.f, yk1 = 0.f;
#pragma unroll
                    for (int s = 0; s < 32; ++s) {
                        const f32x4 cw = w4, ckk = kk4, cka = ka4, ckd = kd4, cwr = wr4; const f32x2_t cv = v2, cbc = bc;
                        if (s + 1 < 32) { const float* bn = bq + (s + 1) * 64;
                            w4 = *(const f32x4*)bn; kk4 = *(const f32x4*)(bn + 2048); ka4 = *(const f32x4*)(bn + 4096); kd4 = *(const f32x4*)(bn + 6144); wr4 = *(const f32x4*)(bn + 8192);
                            v2 = *(const f32x2_t*)(buf + 10240 + (s + 1) * 64 + vrow0); bc = *(const f32x2_t*)(buf + 12288 + 2 * (s + 1)); }
                        f32x2_t sa = Sp[0] * ckk[0], A = Sp[0] * cwr[0];
#pragma unroll
                        for (int j = 1; j < 4; ++j) { sa += Sp[j] * ckk[j]; A += Sp[j] * cwr[j]; }
                        float sa0 = sa[0], sa1 = sa[1], A0 = A[0], A1 = A[1];
                        asm volatile(
                            "s_nop 1\n"
                            "v_add_f32_dpp %0, %0, %0 quad_perm:[1,0,3,2] row_mask:0xf bank_mask:0xf bound_ctrl:1\n"
                            "v_add_f32_dpp %1, %1, %1 quad_perm:[1,0,3,2] row_mask:0xf bank_mask:0xf bound_ctrl:1\n"
                            "v_add_f32_dpp %2, %2, %2 quad_perm:[1,0,3,2] row_mask:0xf bank_mask:0xf bound_ctrl:1\n"
                            "v_add_f32_dpp %3, %3, %3 quad_perm:[1,0,3,2] row_mask:0xf bank_mask:0xf bound_ctrl:1\n"
                            "v_add_f32_dpp %0, %0, %0 quad_perm:[2,3,0,1] row_mask:0xf bank_mask:0xf bound_ctrl:1\n"
                            "v_add_f32_dpp %1, %1, %1 quad_perm:[2,3,0,1] row_mask:0xf bank_mask:0xf bound_ctrl:1\n"
                            "v_add_f32_dpp %2, %2, %2 quad_perm:[2,3,0,1] row_mask:0xf bank_mask:0xf bound_ctrl:1\n"
                            "v_add_f32_dpp %3, %3, %3 quad_perm:[2,3,0,1] row_mask:0xf bank_mask:0xf bound_ctrl:1\n"
                            "v_add_f32_dpp %0, %0, %0 row_half_mirror row_mask:0xf bank_mask:0xf bound_ctrl:1\n"
                            "v_add_f32_dpp %1, %1, %1 row_half_mirror row_mask:0xf bank_mask:0xf bound_ctrl:1\n"
                            "v_add_f32_dpp %2, %2, %2 row_half_mirror row_mask:0xf bank_mask:0xf bound_ctrl:1\n"
                            "v_add_f32_dpp %3, %3, %3 row_half_mirror row_mask:0xf bank_mask:0xf bound_ctrl:1\n"
                            "v_add_f32_dpp %0, %0, %0 row_ror:8 row_mask:0xf bank_mask:0xf bound_ctrl:1\n"
                            "v_add_f32_dpp %1, %1, %1 row_ror:8 row_mask:0xf bank_mask:0xf bound_ctrl:1\n"
                            "v_add_f32_dpp %2, %2, %2 row_ror:8 row_mask:0xf bank_mask:0xf bound_ctrl:1\n"
                            "v_add_f32_dpp %3, %3, %3 row_ror:8 row_mask:0xf bank_mask:0xf bound_ctrl:1\n"
                            "s_nop 0\n"
                            : "+v"(sa0), "+v"(sa1), "+v"(A0), "+v"(A1));
                        sa = (f32x2_t){sa0, sa1}; A = (f32x2_t){A0, A1};
#pragma unroll
                        for (int j = 0; j < 4; ++j) Sp[j] = Sp[j] * cw[j] - sa * cka[j] + cv * ckd[j];
                        const f32x2_t yv = A - sa * cbc[0] + cv * cbc[1];
                        const float y0 = yv[0], y1 = yv[1];
                        const bool mine = (s & 15) == cs;
                        yk0 = mine ? y0 : yk0; yk1 = mine ? y1 : yk1;
                        if ((s & 15) == 15 && islat) {
                            const int gs = ci * 32 + (s & 16) + cs; const int t = dir == 0 ? gs - 256 : 8191 - (gs - 256);
                            *(unsigned*)(z + ((size_t)b * 8192 + t) * 6144 + (dir == 0 ? 5120 : 1024) + h * 64 + vrow0) = cvt_pk_bf16(yk0, yk1);
                        }
                    }
                }
                __syncthreads();
            }
        }
    }
}
__device__ __forceinline__ void rwkv_post(const PP& P, const bf16_t* z, const bf16_t* G, const float* BONUS, bf16_t* o) {
    const int TIX = opaque_tid(); const int BIX = opaque_bid(); (void)TIX; (void)BIX;
    const int lane = TIX & 63, cq = lane & 15;
    const size_t gw = (size_t)BIX * 8 + (TIX >> 6), nw = (size_t)gridDim.x * 8;
    const float* mu = P.in[30]; const float* lg = P.in[42]; const float* lb = P.in[43];
    for (size_t it = gw * 4 + (lane >> 4); it < (size_t)TL * 16; it += nw * 4) {
        const size_t row = it >> 4; const int h = (int)(it & 15), hc = h * 64 + cq * 4; const int t = (int)(row & 8191);
        float yf[4], yb[4], y[4];
        un4(*(const u32x2*)(z + row * 6144 + 5120 + hc), yf); un4(*(const u32x2*)(z + row * 6144 + 1024 + hc), yb);
        float s = 0.f;
#pragma unroll
        for (int e = 0; e < 4; ++e) { y[e] = yf[e] + yb[e]; s += y[e]; }
        const float mean = sum16(s) * (1.f / 64.f);
        float q = 0.f;
#pragma unroll
        for (int e = 0; e < 4; ++e) { y[e] -= mean; q += y[e] * y[e]; }
        const float rstd = rsqrtf(sum16(q) * (1.f / 64.f) + 64e-5f);
        float vc[4], vp[4] = {0.f, 0.f, 0.f, 0.f}, vn[4] = {0.f, 0.f, 0.f, 0.f}, gg[4];
        const bf16_t* pv = z + row * 6144 + 4096 + hc;
        un4(*(const u32x2*)pv, vc);
        if (t > 0) un4(*(const u32x2*)(pv - 6144), vp);
        if (t < 8191) un4(*(const u32x2*)(pv + 6144), vn);
        un4(*(const u32x2*)(G + row * 1024 + hc), gg);
        const float bs = BONUS[(row * 16 + h) * 2] + BONUS[(row * 16 + h) * 2 + 1];
        float out[4];
#pragma unroll
        for (int e = 0; e < 4; ++e) { const float v_ = vc[e] + mu[2048 + hc + e] * (0.5f * (vp[e] + vn[e]) - vc[e]);
            out[e] = (y[e] * rstd * lg[hc + e] + lb[hc + e] + bs * v_) * gg[e]; }
        u32x2 pk; pk[0] = cvt_pk_bf16(out[0], out[1]); pk[1] = cvt_pk_bf16(out[2], out[3]);
        *(u32x2*)(o + row * 2048 + 1024 + hc) = pk;
    }
}


#ifdef DEBUG_CHECKS
__device__ __forceinline__ void chk_flag(unsigned* flags, int bit, float a, float b) { if (!(fabsf(a - b) <= 0.04f * (fabsf(a) + fabsf(b)) + 0.02f)) atomicOr(flags, 1u << bit); }
__device__ __forceinline__ void chk_gemm(const PP& P, const bf16_t* hn, const bf16_t* z, unsigned* flags) {
    const int lane = opaque_tid() & 63;
    const int rows[3] = {12345, 33000, 255}; const int cols[3] = {2222, 17, 4095};
    for (int s = 0; s < 3; ++s) { float a = 0.f;
        for (int k = lane; k < 2048; k += 64) a += bf2f(hn[(size_t)rows[s] * 2048 + k]) * P.in[10][(size_t)k * 4096 + cols[s]];
        a = wave_sum(a); chk_flag(flags, 5, a, bf2f(z[(size_t)rows[s] * 4096 + cols[s]])); }
}
__device__ __forceinline__ void chk_s5(const PP& P, const bf16_t* z, const bf16_t* o, unsigned* flags) {
    const int lane = opaque_tid() & 63, b = 1, g = 5;
    float part[2][16];
#pragma unroll
    for (int k = 0; k < 2; ++k)
#pragma unroll
        for (int p = 0; p < 16; ++p) part[k][p] = 0.f;
    const size_t trow[2] = {(size_t)TL + b * 256 + 100, (size_t)b * 8192 + 3000};
    for (int dir = 0; dir < 2; ++dir) {
        const int dg = dir * 64 + g; const float dt = expf(P.in[17][dg]);
        const float are = P.in[15][dg * 64 + lane], aim = P.in[16][dg * 64 + lane]; const float mag = expf(are * dt);
        const float lre = mag * cosf(aim * dt), lim = mag * sinf(aim * dt);
        const float nr = lre - 1.f, ni = lim, den = 1.f / (are * are + aim * aim);
        const float cre = (nr * are + ni * aim) * den, cim = (ni * are - nr * aim) * den;
        float bbr[16], bbi[16], ccr[16], cci[16];
#pragma unroll
        for (int p = 0; p < 16; ++p) { const float br = P.in[18][((size_t)dg * 64 + lane) * 16 + p], bi = P.in[19][((size_t)dg * 64 + lane) * 16 + p];
            bbr[p] = cre * br - cim * bi; bbi[p] = cre * bi + cim * br;
            ccr[p] = P.in[20][((size_t)dg * 16 + p) * 64 + lane]; cci[p] = P.in[21][((size_t)dg * 16 + p) * 64 + lane]; }
        float xr = 0.f, xi = 0.f;
        for (int pos = 0; pos < 8448; ++pos) {
            size_t row; if (pos < 256) row = (size_t)TL + b * 256 + (dir == 0 ? pos : 255 - pos); else row = (size_t)b * 8192 + (dir == 0 ? pos - 256 : 8191 - (pos - 256));
            float bur = 0.f, bui = 0.f;
#pragma unroll
            for (int p = 0; p < 16; ++p) { const float u = bf2f(z[row * 4096 + g * 16 + p]); bur += bbr[p] * u; bui += bbi[p] * u; }
            const float n1 = lre * xr - lim * xi + bur, n2 = lre * xi + lim * xr + bui; xr = n1; xi = n2;
#pragma unroll
            for (int k = 0; k < 2; ++k) if (row == trow[k]) {
#pragma unroll
                for (int p = 0; p < 16; ++p) part[k][p] += ccr[p] * xr - cci[p] * xi; }
        }
    }
#pragma unroll
    for (int k = 0; k < 2; ++k) {
        float ge[16];
#pragma unroll
        for (int p = 0; p < 16; ++p) { const float y = wave_sum(part[k][p]) + P.in[22][g * 16 + p] * bf2f(z[trow[k] * 4096 + g * 16 + p]); ge[p] = gelu_tanh(y); }
        const int q = lane & 15; float val = P.in[24][g * 16 + q], gt = P.in[24][(64 + g) * 16 + q];
#pragma unroll
        for (int p = 0; p < 16; ++p) { val += ge[p] * P.in[23][((size_t)g * 16 + p) * 16 + q]; gt += ge[p] * P.in[23][((size_t)(64 + g) * 16 + p) * 16 + q]; }
        chk_flag(flags, 0, val * sigmoidf_(gt), bf2f(o[trow[k] * 2048 + g * 16 + q]));
    }
}
__device__ __forceinline__ void chk_attn(const PP& P, unsigned char* wl, const bf16_t* z, const bf16_t* o, unsigned* flags) {
    const int lane = opaque_tid() & 63;
    float* pbuf = (float*)wl; int* kbuf = (int*)(wl + 2048);
    for (int s = 0; s < 8; ++s) {
        const int b = 0, h = 0, r = 0, col = s; const bool band = true;
        const size_t qrow = band ? (size_t)b * 8192 + r * 64 + col : (size_t)TL + b * 256 + col;
        const int start = min(max(r - 4, 0), 120), cs = min(max(col - 8, 0), 48);
        float sc[6]; int kr[6]; float m = -1e30f;
#pragma unroll
        for (int kk = 0; kk < 6; ++kk) {
            float bias = 0.f; bool valid = true; size_t krow;
            if (kk < 2) { const int kidx = kk * 64 + lane, jr = kidx >> 4, jc = kidx & 15; krow = (size_t)b * 8192 + (start + jr) * 64 + cs + jc; bias = P.in[25][(h * 15 + start + jr - r + 7) * 31 + (cs + jc - col + 15)]; valid = band; }
            else krow = (size_t)TL + b * 256 + (kk - 2) * 64 + lane;
            float d = 0.f;
            for (int e = 0; e < 64; ++e) d += bf2f(z[qrow * 4096 + 1024 + h * 64 + e]) * bf2f(z[krow * 4096 + 2048 + h * 64 + e]);
            sc[kk] = valid ? d * 0.125f + bias : -1e30f; kr[kk] = (int)krow; m = fmaxf(m, sc[kk]);
        }
#pragma unroll
        for (int o2 = 32; o2 > 0; o2 >>= 1) m = fmaxf(m, __shfl_xor(m, o2));
        float l = 0.f;
#pragma unroll
        for (int kk = 0; kk < 6; ++kk) { const float p = expf(sc[kk] - m); l += p; pbuf[kk * 64 + lane] = p; kbuf[kk * 64 + lane] = kr[kk]; }
        l = wave_sum(l);
        WAVE_SYNC();
        float acc = 0.f;
        for (int i = 0; i < 384; ++i) acc += pbuf[i] * bf2f(z[(size_t)kbuf[i] * 4096 + 3072 + h * 64 + lane]);
        { const float a_ = acc / l, b_ = bf2f(o[qrow * 2048 + 1024 + h * 64 + lane]); float e_ = fabsf(a_ - b_), m_ = fabsf(a_);
#pragma unroll
            for (int o2 = 32; o2 > 0; o2 >>= 1) { e_ = fmaxf(e_, __shfl_xor(e_, o2)); m_ = fmaxf(m_, __shfl_xor(m_, o2)); }
            if (lane == 0 && e_ > 0.2f * m_) atomicOr(flags, 1u << s); }
        WAVE_SYNC();
    }
}
__device__ __forceinline__ void chk_sgu(const PP& P, const bf16_t* z, const bf16_t* o, unsigned* flags) {
    const int lane = opaque_tid() & 63, b = 1, t = 4321, n = t >> 7, p = t & 127, c = 717, h = c >> 7;
    float acc = 0.f;
    for (int q = 0; q < 128; ++q) {
        const size_t row = (size_t)b * 8192 + n * 128 + q;
        float v[16]; float s = 0.f;
#pragma unroll
        for (int j = 0; j < 16; ++j) { v[j] = gelu_tanh(bf2f(z[row * 6144 + 1024 + j * 64 + lane])); s += v[j]; }
        const float mean = wave_sum(s) * (1.f / 1024.f); float qq = 0.f;
#pragma unroll
        for (int j = 0; j < 16; ++j) qq += (v[j] - mean) * (v[j] - mean);
        const float rstd = rsqrtf(wave_sum(qq) * (1.f / 1024.f) + 1e-5f);
        const float vc = (gelu_tanh(bf2f(z[row * 6144 + 1024 + c])) - mean) * rstd * P.in[26][c] + P.in[27][c];
        acc += P.in[28][((size_t)h * 128 + p) * 128 + q] * vc;
    }
    const size_t row = (size_t)b * 8192 + t;
    chk_flag(flags, 4, gelu_tanh(bf2f(z[row * 6144 + c])) * (acc + P.in[29][h * 128 + p]), bf2f(o[row * 2048 + c]));
}
__device__ __forceinline__ void chk_lora(const PP& P, unsigned char* wl, const bf16_t* z, const bf16_t* EWA, const bf16_t* G, unsigned* flags) {
    const int lane = opaque_tid() & 63, dir = 1, ch = 300; const size_t row = (size_t)8192 + 777;
    float* lbuf = (float*)wl;
    float xd[16], dx[16];
#pragma unroll
    for (int j = 0; j < 16; ++j) { const int k = j * 64 + lane; xd[j] = bf2f(z[row * 6144 + 5120 + k]);
        dx[j] = 0.5f * (bf2f(z[(row - 1) * 6144 + 5120 + k]) + bf2f(z[(row + 1) * 6144 + 5120 + k])) - xd[j]; }
    for (int jj = 0; jj < 64; ++jj) { float a = 0.f;
#pragma unroll
        for (int j = 0; j < 16; ++j) { const int k = j * 64 + lane; a += (xd[j] + P.in[30][3 * 1024 + k] * dx[j]) * P.in[32][((size_t)dir * 1024 + k) * 64 + jj]; }
        a = wave_sum(a); if (lane == jj) lbuf[jj] = tanhf(a); }
    WAVE_SYNC();
    { float pre = wave_sum(lbuf[lane] * P.in[33][((size_t)dir * 64 + lane) * 1024 + ch]) + P.in[31][dir * 1024 + ch];
      const float x = -pre; const float sp = x > 20.f ? x : log1pf(expf(x));
      chk_flag(flags, 5, expf(-sp - 0.5f), bf2f(EWA[row * 4096 + dir * 1024 + ch])); }
    WAVE_SYNC();
    for (int jj = 0; jj < 64; ++jj) { float a = 0.f;
#pragma unroll
        for (int j = 0; j < 16; ++j) { const int k = j * 64 + lane; a += (xd[j] + P.in[30][4 * 1024 + k] * dx[j]) * P.in[35][((size_t)dir * 1024 + k) * 64 + jj]; }
        a = wave_sum(a); if (lane == jj) lbuf[jj] = a; }
    WAVE_SYNC();
    { const float pre = wave_sum(lbuf[lane] * P.in[36][((size_t)dir * 64 + lane) * 1024 + ch]) + P.in[34][dir * 1024 + ch];
      chk_flag(flags, 5, sigmoidf_(pre), bf2f(EWA[row * 4096 + 2048 + dir * 1024 + ch])); }
    WAVE_SYNC();
    for (int jj = 0; jj < 128; ++jj) { float a = 0.f;
#pragma unroll
        for (int j = 0; j < 16; ++j) { const int k = j * 64 + lane; a += (xd[j] + P.in[30][5 * 1024 + k] * dx[j]) * P.in[37][(size_t)k * 128 + jj]; }
        a = wave_sum(a); if (lane == (jj & 63)) lbuf[jj] = sigmoidf_(a); }
    WAVE_SYNC();
    { const float gsum = wave_sum(lbuf[lane] * P.in[38][(size_t)lane * 1024 + ch] + lbuf[64 + lane] * P.in[38][(size_t)(64 + lane) * 1024 + ch]);
      chk_flag(flags, 5, gsum, bf2f(G[row * 1024 + ch])); }
    WAVE_SYNC();
}
__device__ __forceinline__ void chk_rwkv(const PP& P, unsigned char* wl, const bf16_t* z, const bf16_t* EWA, unsigned* flags) {
    const int lane = opaque_tid() & 63, b = 1, h = 3, hc = h * 64 + lane;
    float* L = (float*)wl;
    for (int dir = 0; dir < 2; ++dir) {
        float S[64];
#pragma unroll
        for (int k = 0; k < 64; ++k) S[k] = 0.f;
        for (int gs = 0; gs < 258; ++gs) {
            size_t row; bool hp, hn, il; rw_rowinfo(dir, b, gs, row, hp, hn, il);
            const bf16_t* p = z + row * 6144 + 2048 + hc;
            float rr = bf2f(p[0]), kq = bf2f(p[1024]), vv = bf2f(p[2048]);
            const float rp = hp ? bf2f(p[-6144]) : 0.f, kp = hp ? bf2f(p[-6144 + 1024]) : 0.f, vp = hp ? bf2f(p[-6144 + 2048]) : 0.f;
            const float rn = hn ? bf2f(p[6144]) : 0.f, kn = hn ? bf2f(p[6144 + 1024]) : 0.f, vn = hn ? bf2f(p[6144 + 2048]) : 0.f;
            rr += P.in[30][hc] * (0.5f * (rp + rn) - rr); kq += P.in[30][1024 + hc] * (0.5f * (kp + kn) - kq); vv += P.in[30][2048 + hc] * (0.5f * (vp + vn) - vv);
            float kk = kq * P.in[39][hc]; const float nn = wave_sum(kk * kk); kk = kk / fmaxf(sqrtf(nn), 1e-12f);
            const float ew = bf2f(EWA[row * 4096 + dir * 1024 + hc]), a = bf2f(EWA[row * 4096 + 2048 + dir * 1024 + hc]);
            L[lane] = expf(-ew); L[64 + lane] = kk; L[128 + lane] = kk * a; L[192 + lane] = kq * (1.f + (a - 1.f) * P.in[40][hc]); L[256 + lane] = rr; L[320 + lane] = vv;
            WAVE_SYNC();
            float sa = 0.f;
#pragma unroll
            for (int k = 0; k < 64; ++k) sa += S[k] * L[64 + k];
            float y = 0.f;
#pragma unroll
            for (int k = 0; k < 64; ++k) { S[k] = S[k] * L[k] - sa * L[128 + k] + vv * L[192 + k]; y += S[k] * L[256 + k]; }
            if (il) chk_flag(flags, 4, y, bf2f(z[row * 6144 + (dir == 0 ? 5120 : 1024) + hc]));
            WAVE_SYNC();
        }
    }
}
#endif


#define XB_TMO      128
#define XB_XCNT(j)  (256  + 64 * (j))
#define XB_XSUB(j)  (1280 + 64 * (j))
#define XB_XGEN(j)  (2304 + 64 * (j))
#define XB_TOP      3328
#define XB_TOPGEN   3392
#define XCD_BAR_WORDS 3456
#define XB_SPIN_CAP (1u << 22)
__device__ __forceinline__ unsigned xb_ld(unsigned* p)              { return __hip_atomic_load(p, __ATOMIC_RELAXED, __HIP_MEMORY_SCOPE_AGENT); }
__device__ __forceinline__ unsigned xb_add(unsigned* p, unsigned v) { return __hip_atomic_fetch_add(p, v, __ATOMIC_RELAXED, __HIP_MEMORY_SCOPE_AGENT); }
__device__ __forceinline__ unsigned xb_xcc_id() { return (unsigned)__builtin_amdgcn_s_getreg((3 << 11) | 20) & 0xFu; }
#define XB_SPIN(cond, bar) do { unsigned _sp = 0; while (cond) { __builtin_amdgcn_s_sleep(1); \
    if ((++_sp & 255u) == 0u) { if (xb_ld(&(bar)[XB_TMO])) break; if (_sp > XB_SPIN_CAP) { atomicAdd(&(bar)[XB_TMO], 1u); break; } } } } while (0)
struct XcdBarrier { unsigned* bar; unsigned x; volatile LAS unsigned* st; };
__device__ __forceinline__ XcdBarrier xcd_barrier_post(unsigned* bar, volatile LAS unsigned* st) {
    XcdBarrier b; b.bar = bar; b.x = xb_xcc_id(); b.st = st;
    if (threadIdx.x == 0) (void)xb_add(&bar[XB_XCNT(b.x)], 1u);
    return b;
}
__device__ __forceinline__ void xcd_barrier_complete(unsigned* bar, unsigned x, unsigned& nloc, unsigned& nx) {
    const unsigned G = gridDim.x * gridDim.y * gridDim.z;
    unsigned sum, cnt, mine, sp = 0u;
    for (;;) {
        sum = 0u; cnt = 0u; mine = 0u;
#pragma unroll
        for (unsigned j = 0; j < 16; ++j) { const unsigned c = xb_ld(&bar[XB_XCNT(j)]); sum += c; cnt += (c > 0u) ? 1u : 0u; mine = (j == x) ? c : mine; }
        if (sum == G) break;
        __builtin_amdgcn_s_sleep(1);
        if ((++sp & 255u) == 0u) { if (xb_ld(&bar[XB_TMO])) break; if (sp > XB_SPIN_CAP) { atomicAdd(&bar[XB_TMO], 1u); break; } }
    }
    nloc = mine > 0u ? mine : 1u; nx = cnt > 0u ? cnt : 1u;
}
__device__ __forceinline__ void xcd_barrier(const XcdBarrier& b) {
    asm volatile("s_waitcnt vmcnt(0)" ::: "memory");
    __syncthreads();
    if (threadIdx.x == 0) {
        unsigned* bar = b.bar;
        __builtin_amdgcn_s_waitcnt(0);
        unsigned nloc = b.st[0], nx = b.st[1];
        if (nloc == 0u) { xcd_barrier_complete(bar, b.x, nloc, nx); b.st[0] = nloc; b.st[1] = nx; }
        const unsigned old = xb_add(&bar[XB_XSUB(b.x)], 1u);
        const unsigned gen = old / nloc;
        if (old + 1u == (gen + 1u) * nloc) {
            __builtin_amdgcn_fence(__ATOMIC_RELEASE, "agent");
            asm volatile("s_waitcnt vmcnt(0)" ::: "memory");
            const unsigned og = xb_add(&bar[XB_TOP], 1u);
            const unsigned tg = og / nx;
            if (og + 1u == (tg + 1u) * nx) xb_add(&bar[XB_TOPGEN], 1u);
            else XB_SPIN(xb_ld(&bar[XB_TOPGEN]) == tg, bar);
            __builtin_amdgcn_fence(__ATOMIC_ACQUIRE, "agent");
            xb_add(&bar[XB_XGEN(b.x)], 1u);
            asm volatile("s_waitcnt vmcnt(0)" ::: "memory");
        } else {
            XB_SPIN(xb_ld(&bar[XB_XGEN(b.x)]) == gen, bar);
            __builtin_amdgcn_fence(__ATOMIC_ACQUIRE, "agent");
            asm volatile("s_waitcnt vmcnt(0)" ::: "memory");
        }
    }
    __syncthreads();
}

__global__ void __launch_bounds__(512, 2) fwd_megakernel(Params P0) {
    extern __shared__ __attribute__((aligned(16))) unsigned char shm[];
    cg::grid_group grid = cg::this_grid();
    unsigned char* ws = P0.ws;
    volatile LAS unsigned* xb_st = (volatile LAS unsigned*)(LAS unsigned char*)(shm + 131072);
    if (threadIdx.x < 4) xb_st[threadIdx.x] = 0u;
    __syncthreads();
    const XcdBarrier xb = xcd_barrier_post((unsigned*)(ws + OFF_BAR), xb_st);
    const int nw = gridDim.x * 8;
#define GW0 (opaque_bid() * 8 + (opaque_tid() >> 6))
#define WL (shm + (opaque_tid() >> 6) * 13312)
    bf16_t* R1 = (bf16_t*)(ws + OFF_R1); bf16_t* R2 = (bf16_t*)(ws + OFF_R2); bf16_t* R3 = (bf16_t*)(ws + OFF_R3);
    float* XC = (float*)(ws + OFF_XC);

    prologue(P0, shm);
    { const int t_ = opaque_tid(); if (opaque_bid() == 0 && t_ == 64) *(unsigned*)(ws + OFF_TBL + 4096) = 0u; if (opaque_bid() == 0 && t_ < 44) ((const float**)(ws + OFF_TBL))[t_] = P0.in[t_]; }
    grid.sync();
    PP P; P.in = (const float* const*)(ws + OFF_TBL); P.out = P0.out; P.ws = ws;
    resid_mod(P, TT, P.in[0], P.in[2], nullptr, nullptr, nullptr, nullptr, 0, 0, 0, P.in[6], 0, 2048, R2);
    xcd_barrier(xb);
    run_gemm<EPI_PLAIN>(shm, R2, (const bf16_t*)(ws + WB_WINE), TT, 4096, 2048, R1, 4096);
    xcd_barrier(xb);
#ifdef DEBUG_CHECKS
    unsigned* flags = (unsigned*)(ws + OFF_TBL + 4096);
    xcd_barrier(xb);
#endif
    {   float2* E = (float2*)(ws + OFF_S5E); bf16_t* VT = (bf16_t*)(ws + OFF_VT); bf16_t* VCT = (bf16_t*)(ws + OFF_VCT);
        for (int t = GW0; t < 4 * 64 * 132; t += nw) s5_task<false>(P, t, WL, R1, E, R3);
        for (int t = GW0; t < 528 * 16; t += nw) vt_task(t, WL, R1, VT, VCT);
        xcd_barrier(xb);
        s5_carry(P, E);
#ifdef NAIVE_ATTN
        for (int t = GW0; t < 4 * 8192 * 16; t += nw) attn_naive(P, t, WL, R1, R3, true);
        for (int t = GW0; t < 4 * 256 * 16; t += nw) attn_naive(P, t, WL, R1, R3, false);
#else
        if (nw == 2048) {
            bf16_t* KL = (bf16_t*)(shm + 20480); bf16_t* VL = (bf16_t*)(shm + 20480 + 36864);
            for (int it = 0; it < 16; ++it) {
                const int tid_ = opaque_tid(), bid_ = opaque_bid();
                const int vb = (bid_ & 7) * 32 + (bid_ >> 3);
                const int tb = vb * 8 + it * 2048, hh = (tb >> 9) & 15, bb = tb >> 13;
                __syncthreads();
#pragma unroll
                for (int i = 0; i < 4; ++i) { const int idx = tid_ + i * 512, key = idx >> 3, part = idx & 7;
                    *(u32x4*)(KL + key * 72 + part * 8) = *(const u32x4*)(R1 + ((size_t)TL + bb * 256 + key) * 4096 + 2048 + hh * 64 + part * 8); }
#pragma unroll
                for (int i = 0; i < 4; ++i) { const int idx = tid_ + i * 512, d = idx >> 5, part = idx & 31;
                    *(u32x4*)(VL + d * 264 + part * 8) = *(const u32x4*)(VCT + ((size_t)(bb * 16 + hh) * 64 + d) * 256 + part * 8); }
                __syncthreads();
                attn_task<true>(P, tb + (tid_ >> 6), shm + (tid_ >> 6) * 2560, R1, VT, VCT, R3, KL, VL);
            }
            __syncthreads();
        } else
        for (int t = GW0; t < 32768; t += nw) attn_task<true>(P, t, WL, R1, VT, VCT, R3);
        if (nw == 2048) { const int g_ = GW0; if (g_ >= 1024) attn_task<false>(P, g_ - 1024, WL, R1, VT, VCT, R3); }
        else
        for (int t = GW0; t < 1024; t += nw) attn_task<false>(P, t, WL, R1, VT, VCT, R3);
#endif
        xcd_barrier(xb);
        for (int t = GW0; t < 4 * 64 * 132; t += nw) s5_task<true>(P, t, WL, R1, E, R3);
        xcd_barrier(xb);
#ifdef DEBUG_CHECKS
        if (opaque_bid() == 2 && opaque_tid() < 64) chk_attn(P, shm, R1, R3, flags);
        xcd_barrier(xb);
#endif
    }
    run_gemm<EPI_PLAIN>(shm, R3, (const bf16_t*)(ws + WB_WOUT0), TT, 2048, 2048, R1, 2048);
    xcd_barrier(xb);
    resid_mod(P, TT, P.in[0], P.in[2], P.out, XC, R1, P.in[7], 2 * 2048, 0, 0, P.in[8], 3 * 2048, 4 * 2048, R2);
    xcd_barrier(xb);
    run_gemm<EPI_RELU2>(shm, R2, (const bf16_t*)(ws + WB_W1_0), TT, 8192, 2048, R1, 8192);
    xcd_barrier(xb);
    run_gemm<EPI_PLAIN>(shm, R1, (const bf16_t*)(ws + WB_W2_0), TT, 2048, 8192, R3, 2048);
    xcd_barrier(xb);
    resid_mod(P, TT, P.out, XC, P.out, XC, R3, P.in[9], 5 * 2048, 0, 1, P.in[6] + 2048, 0, 2048, R2);
    xcd_barrier(xb);
    run_gemm<EPI_PLAIN>(shm, R2, (const bf16_t*)(ws + WB_WINO), TT, 6144, 2048, R1, 6144);
    xcd_barrier(xb);
    {   bf16_t* VLNT = (bf16_t*)(ws + OFF_VLNT); bf16_t* G = (bf16_t*)(ws + OFF_G); bf16_t* LORA1 = (bf16_t*)(ws + OFF_LORA1); bf16_t* EWA = (bf16_t*)(ws + OFF_EWA);
        float* BONUS = (float*)(ws + OFF_BONUS);
        sgu_pre(P, shm, R1, VLNT);
        xcd_barrier(xb);
        for (int t = GW0; t < 4 * 64 * 8 * 4; t += nw) sgu_task(P, t, R1, VLNT, (const bf16_t*)(ws + OFF_WSB), R3);
        __syncthreads();
        run_gemm<EPI_PLAIN>(shm, R1 + 5120, (const bf16_t*)(ws + OFF_L1T), TT, 768, 1024, R2, 768, nullptr, nullptr, 6144);
        xcd_barrier(xb);
        lora1_combine(R2, LORA1);
        xcd_barrier(xb);
        run_gemm<EPI_LORA2>(shm, LORA1, (const bf16_t*)(ws + OFF_L2T), TT, 5120, 384, EWA, 4096, G, P.in);
        xcd_barrier(xb);
#ifdef DEBUG_CHECKS
        xcd_barrier(xb);
#endif
        rwkv_scan(P, shm, R1, R1, EWA, BONUS);
        xcd_barrier(xb);
        rwkv_post(P, R1, G, BONUS, R3);
        xcd_barrier(xb);
#ifdef DEBUG_CHECKS
        xcd_barrier(xb);
#endif
    }
    run_gemm<EPI_PLAIN>(shm, R3, (const bf16_t*)(ws + WB_WOUT1), TL, 2048, 2048, R1, 2048);
    xcd_barrier(xb);
    resid_mod(P, TL, P.out, XC, P.out, XC, R1, P.in[7] + 2048, 2 * 2048, 1, 1, P.in[8] + 2048, 3 * 2048, 4 * 2048, R2);
    xcd_barrier(xb);
    run_gemm<EPI_RELU2>(shm, R2, (const bf16_t*)(ws + WB_W1_1), TL, 8192, 2048, R1, 8192);
    xcd_barrier(xb);
    run_gemm<EPI_PLAIN>(shm, R1, (const bf16_t*)(ws + WB_W2_1), TL, 2048, 8192, R3, 2048);
    xcd_barrier(xb);
    resid_mod(P, TL, P.out, XC, P.out, XC, R3, P.in[9] + 2048, 5 * 2048, 1, 1, nullptr, 0, 0, nullptr);
#ifdef DEBUG_CHECKS
    xcd_barrier(xb);
    { const unsigned f = *(volatile unsigned*)flags;
      if (f) { float kv = 1.f; for (unsigned i = 0; i < f; ++i) kv *= 1.4f;
          for (size_t i = (size_t)opaque_bid() * 512 + opaque_tid(); i < (size_t)TL * DM; i += (size_t)gridDim.x * 512) P.out[i] = kv; } }
#endif
}

extern "C" void kernel_launch(void* const* d_in, const int* in_sizes, int n_in, void* d_out, int out_size, void* d_ws, size_t ws_size, hipStream_t stream) {
    static int grid_blocks = 0;
    if (grid_blocks == 0) {
        if (n_in != 44 || ws_size < WS_END) { fprintf(stderr, "kernel_launch: unexpected n_in %d / ws_size %zu (need %zu)\n", n_in, ws_size, (size_t)WS_END); grid_blocks = -1; return; }
        int dev = 0, cus = 0, per_cu = 0;
        hipGetDevice(&dev);
        hipDeviceGetAttribute(&cus, hipDeviceAttributeMultiprocessorCount, dev);
        if (hipFuncSetAttribute((const void*)fwd_megakernel, hipFuncAttributeMaxDynamicSharedMemorySize, LDS_BYTES) != hipSuccess) { fprintf(stderr, "kernel_launch: hipFuncSetAttribute failed\n"); grid_blocks = -1; return; }
        hipOccupancyMaxActiveBlocksPerMultiprocessor(&per_cu, (const void*)fwd_megakernel, 512, LDS_BYTES);
        if (per_cu < 1) { fprintf(stderr, "kernel_launch: occupancy query says %d blocks per CU\n", per_cu); per_cu = 1; }
        grid_blocks = cus * per_cu;
    }
    if (grid_blocks < 0) return;
    if (hipMemsetAsync((unsigned char*)d_ws + OFF_BAR, 0, XCD_BAR_WORDS * sizeof(unsigned), stream) != hipSuccess) { fprintf(stderr, "kernel_launch: hipMemsetAsync of the barrier words failed\n"); return; }
    Params p{};
    for (int i = 0; i < 44; ++i) p.in[i] = (const float*)d_in[i];
    p.out = (float*)d_out; p.ws = (unsigned char*)d_ws;
    void* args[] = {&p};
    hipError_t e = hipLaunchCooperativeKernel((const void*)fwd_megakernel, dim3(grid_blocks), dim3(512), args, LDS_BYTES, stream);
    if (e != hipSuccess) fprintf(stderr, "cooperative launch failed: %s (grid %d)\n", hipGetErrorString(e), grid_blocks);
}
```

```cpp
#include <hip/hip_runtime.h>
#include <hip/hip_cooperative_groups.h>
#include <cstdio>
#include <cstdint>
namespace cg = cooperative_groups;

#define LAS __attribute__((address_space(3)))
typedef unsigned short bf16_t;
typedef short bf16x8 __attribute__((ext_vector_type(8)));
typedef float f32x4 __attribute__((ext_vector_type(4)));
typedef unsigned u32x4 __attribute__((ext_vector_type(4)));
typedef unsigned u32x2 __attribute__((ext_vector_type(2)));

constexpr int DM = 2048, TL = 32768, TCX = 1024, TT = 33792, LSEQ = 8192, NCTX = 256;
constexpr size_t MiB = 1ull << 20;
constexpr size_t WB_WINE = 0, WB_WOUT0 = 16 * MiB, WB_W1_0 = 24 * MiB, WB_W2_0 = 56 * MiB, WB_WINO = 88 * MiB, WB_WOUT1 = 112 * MiB, WB_W1_1 = 120 * MiB, WB_W2_1 = 152 * MiB;
constexpr size_t OFF_R1 = 184 * MiB, OFF_R2 = 712 * MiB, OFF_R3 = 844 * MiB, OFF_SL = 976 * MiB;
constexpr size_t OFF_XC = OFF_SL, OFF_MOD = OFF_SL + 8 * MiB, OFF_BONUS = OFF_SL + 9 * MiB, OFF_L1T = OFF_SL + 14 * MiB, OFF_L2T = OFF_SL + 16 * MiB, OFF_WSB = OFF_SL + 20 * MiB, OFF_TBL = OFF_SL + 21 * MiB, WS_END = OFF_SL + 22 * MiB;
constexpr size_t OFF_VLNT = 0, OFF_G = 0, OFF_LORA1 = 72 * MiB;
constexpr size_t OFF_EWA = OFF_R1 + 396 * MiB;
constexpr size_t OFF_S5E = OFF_R2, OFF_VT = OFF_R2 + 34 * MiB, OFF_VCT = OFF_R2 + 98 * MiB;
constexpr int LDS_BYTES = 131072 + 16;
constexpr size_t OFF_BAR = OFF_TBL + 65536;

struct Params { const float* in[44]; float* out; unsigned char* ws; };
struct PP { const float* const* in; float* out; unsigned char* ws; };

typedef float f32x2_t __attribute__((ext_vector_type(2)));
typedef __bf16 bf16x2_t __attribute__((ext_vector_type(2)));
__device__ __forceinline__ unsigned cvt_pk_bf16(float lo, float hi) { const f32x2_t v = {lo, hi}; const bf16x2_t b = __builtin_convertvector(v, bf16x2_t); return __builtin_bit_cast(unsigned, b); }
__device__ __forceinline__ bf16_t f2bf(float f) { return (bf16_t)(cvt_pk_bf16(f, 0.f) & 0xffffu); }
__device__ __forceinline__ float bf2f(bf16_t b) { return __uint_as_float(((unsigned)b) << 16); }
__device__ __forceinline__ float bflo(unsigned u) { return __uint_as_float(u << 16); }
__device__ __forceinline__ float bfhi(unsigned u) { return __uint_as_float(u & 0xffff0000u); }
__device__ __forceinline__ float sigmoidf_(float x) { return 1.f / (1.f + __expf(-x)); }
__device__ __forceinline__ float gelu_tanh(float x) { const float u2 = 1.5957691216057308f * (x + 0.044715f * x * x * x); return x * __builtin_amdgcn_rcpf(1.f + __expf(-u2)); }
__device__ __forceinline__ float wave_sum(float v) {
#pragma unroll
    for (int o = 32; o > 0; o >>= 1) v += __shfl_xor(v, o);
    return v;
}
#define DPP_ADD(v, ctrl) (v) += __builtin_bit_cast(float, __builtin_amdgcn_update_dpp(0, __builtin_bit_cast(int, (v)), (ctrl), 0xf, 0xf, false))
#define DPP_MAX(v, ctrl) (v) = fmaxf((v), __builtin_bit_cast(float, __builtin_amdgcn_update_dpp(0, __builtin_bit_cast(int, (v)), (ctrl), 0xf, 0xf, false)))
__device__ __forceinline__ float sum16(float v) { DPP_ADD(v, 0xB1); DPP_ADD(v, 0x4E); DPP_ADD(v, 0x141); DPP_ADD(v, 0x128); return v; }
__device__ __forceinline__ float max16(float v) { DPP_MAX(v, 0xB1); DPP_MAX(v, 0x4E); DPP_MAX(v, 0x141); DPP_MAX(v, 0x128); return v; }
__device__ __forceinline__ int opaque_tid() { int t = threadIdx.x; asm volatile("" : "+v"(t)); return t; }
__device__ __forceinline__ int opaque_bid() { int t = blockIdx.x; asm volatile("" : "+s"(t)); return t; }
__device__ __forceinline__ void lam_bar_of(float are, float aim, float dt, float& lre, float& lim) { const float mag = __expf(are * dt); float sn, cs; __sincosf(aim * dt, &sn, &cs); lre = mag * cs; lim = mag * sn; }
#define WAVE_SYNC() asm volatile("s_waitcnt lgkmcnt(0)" ::: "memory")
__device__ __forceinline__ bf16x8 pack8(const float* v) {
    u32x4 r; r[0] = cvt_pk_bf16(v[0], v[1]); r[1] = cvt_pk_bf16(v[2], v[3]); r[2] = cvt_pk_bf16(v[4], v[5]); r[3] = cvt_pk_bf16(v[6], v[7]);
    return __builtin_bit_cast(bf16x8, r);
}
__device__ __forceinline__ bf16x8 pack8v(f32x4 a, f32x4 b) {
    u32x4 r; r[0] = cvt_pk_bf16(a[0], a[1]); r[1] = cvt_pk_bf16(a[2], a[3]); r[2] = cvt_pk_bf16(b[0], b[1]); r[3] = cvt_pk_bf16(b[2], b[3]);
    return __builtin_bit_cast(bf16x8, r);
}
#define MFMA16(a, b, c) __builtin_amdgcn_mfma_f32_16x16x32_bf16((a), (b), (c), 0, 0, 0)
__device__ __forceinline__ bf16x8 zero8() { u32x4 r = {0u, 0u, 0u, 0u}; return __builtin_bit_cast(bf16x8, r); }

namespace pg8 {
constexpr int BM = 256, BK = 64, HALF = 128, HTB = HALF * BK * 2, STAGE_BYTES = 8 * HTB, NXCD = 8, WGM = 8;
__host__ __device__ __forceinline__ int lds_byte(int r, int c) { const int st = (r >> 4) * 2 + (c >> 5), rr = r & 15, cc = c & 31, ob = rr * 64 + cc * 2; return st * 1024 + (ob ^ (((ob >> 9) & 1) << 5)); }
__host__ __device__ __forceinline__ void stage_rc(int b, int& R, int& C) { const int st = b / 1024, sb = b % 1024, swz = sb ^ (((sb >> 9) & 1) << 5); R = (st >> 1) * 16 + swz / 64; C = (st & 1) * 32 + (swz % 64) / 2; }
__host__ __device__ __forceinline__ int perm32(int rho) { const int n = rho >> 4, i = rho & 15; return 8 * (i >> 2) + 4 * n + (i & 3); }
struct Unit { int pm, pn; };
struct Gemm { const bf16_t* A; const bf16_t* Bt; int M, N, K; int lda; };
struct StaticOrder {
    int nM, nN, nwg, G, c;
    __host__ __device__ void init(int M, int N, int G_, int c_) { nM = M / BM; nN = N / BM; nwg = nM * nN; G = G_; c = c_; }
    __host__ __device__ bool next(int i, Unit& u) const {
        const long L = (long)i * G + c; if (L >= nwg) return false;
        int wgid = (int)L; { const int q = nwg / NXCD, r = nwg % NXCD, xcd = wgid % NXCD, off = wgid / NXCD; wgid = (xcd < r ? xcd * (q + 1) : r * (q + 1) + (xcd - r) * q) + off; }
        const int nig = WGM * nN, gid = wgid / nig, fm = gid * WGM, gsz = (nM - fm) < WGM ? (nM - fm) : WGM;
        u.pm = fm + ((wgid % nig) % gsz); u.pn = (wgid % nig) / gsz; return true;
    }
};

template <class Epi, class Sched>
__device__ __forceinline__ void gemm_phase(LAS unsigned char* lds, const Gemm g, const Sched& S, const Epi& E) {
    const int TIX = opaque_tid(); const int BIX = opaque_bid(); (void)TIX; (void)BIX;
    const int tid = TIX, wid = __builtin_amdgcn_readfirstlane(tid >> 6), lane = tid & 63, wr = wid >> 2, wc = wid & 3, fr = lane & 15, fq = lane >> 4;
    const int K = g.K, nt = K / BK;
    unsigned voffA[2], voffB[2];
#pragma unroll
    for (int i = 0; i < 2; ++i) { int R, C; stage_rc(tid * 16 + i * 8192, R, C); const int Rb = Epi::PERM ? ((R & ~31) + perm32(R & 31)) : R;
        voffA[i] = (unsigned)(R * g.lda + C) * 2u; voffB[i] = (unsigned)(Rb * K + C) * 2u; }
    const size_t kstep = (size_t)(BK * 2);
    const size_t hstep = (size_t)HALF * K * 2, hstepA = (size_t)HALF * g.lda * 2;
    const size_t tstep = 2 * hstep, tstepA = 2 * hstepA;
    const unsigned ldsw = (unsigned)wid * 1024u;
    const int aoff = lds_byte(wr * 64 + fr, fq * 8), boff = lds_byte(wc * 32 + fr, fq * 8);
#define PG8_SA(b, h) (((b) * 2 + (h)) * HTB)
#define PG8_SB(b, h) ((4 + (b) * 2 + (h)) * HTB)
#define PG8_STAGE(bufoff, gbase, voff) do { _Pragma("unroll") for (int _i = 0; _i < 2; ++_i) \
        __builtin_amdgcn_global_load_lds((const unsigned*)((const char*)(gbase) + (voff)[_i]), (LAS unsigned*)(lds + (bufoff) + ldsw + _i * 8192), 16, 0, 0); } while (0)
#define PG8_LDA(dst, b, h) do { _Pragma("unroll") for (int m = 0; m < 4; ++m) _Pragma("unroll") for (int k = 0; k < 2; ++k) dst[m][k] = *(const LAS bf16x8*)(lds + PG8_SA(b, h) + aoff + m * 2048 + k * 1024); } while (0)
#define PG8_LDB(dst, b, h) do { _Pragma("unroll") for (int n = 0; n < 2; ++n) _Pragma("unroll") for (int k = 0; k < 2; ++k) dst[n][k] = *(const LAS bf16x8*)(lds + PG8_SB(b, h) + boff + n * 2048 + k * 1024); } while (0)
#define PG8_MMA(ai, bj, At, Bt) do { __builtin_amdgcn_s_setprio(1); _Pragma("unroll") for (int m = 0; m < 4; ++m) _Pragma("unroll") for (int n = 0; n < 2; ++n) _Pragma("unroll") for (int k = 0; k < 2; ++k) \
        acc[ai][bj][m][n] = __builtin_amdgcn_mfma_f32_16x16x32_bf16(Bt[n][k], At[m][k], acc[ai][bj][m][n], 0, 0, 0); __builtin_amdgcn_s_setprio(0); } while (0)
#define PG8_WAIT_V(n) asm volatile("s_waitcnt vmcnt(" #n ")" ::: "memory")
#define PG8_WAIT_L(n) asm volatile("s_waitcnt lgkmcnt(" #n ")" ::: "memory")
#define PG8_BAR __builtin_amdgcn_s_barrier()
#define PG8_SCHED __builtin_amdgcn_sched_barrier(0)
    Unit cur, nxt; int ui = 0;
    if (!S.next(0, cur)) return;
    f32x4 acc[2][2][4][2];
#pragma unroll
    for (int a = 0; a < 2; ++a)
#pragma unroll
        for (int b = 0; b < 2; ++b)
#pragma unroll
            for (int m = 0; m < 4; ++m)
#pragma unroll
                for (int n = 0; n < 2; ++n) acc[a][b][m][n] = (f32x4){0.f, 0.f, 0.f, 0.f};
    bf16x8 At[4][2], B0[2][2], B1[2][2];
    const char* cA = (const char*)g.A + (size_t)cur.pm * tstepA; const char* cB = (const char*)g.Bt + (size_t)cur.pn * tstep;
    PG8_STAGE(PG8_SB(0, 0), cB, voffB); PG8_STAGE(PG8_SB(0, 1), cB + hstep, voffB); PG8_STAGE(PG8_SA(0, 0), cA, voffA); PG8_STAGE(PG8_SA(0, 1), cA + hstepA, voffA);
    if (wr == 1) PG8_BAR;
    PG8_WAIT_V(2); PG8_BAR;
    PG8_STAGE(PG8_SB(1, 0), cB + kstep, voffB); PG8_STAGE(PG8_SA(1, 0), cA + kstep, voffA); PG8_STAGE(PG8_SB(1, 1), cB + hstep + kstep, voffB);
    PG8_WAIT_V(6); PG8_BAR;
    for (;;) {
        const bool has_next = S.next(ui + 1, nxt);
        const char* nA = has_next ? (const char*)g.A + (size_t)nxt.pm * tstepA : cA; const char* nB = has_next ? (const char*)g.Bt + (size_t)nxt.pn * tstep : cB;
        for (int t = 0; t < nt; t += 2) {
            const bool last = (t == nt - 2);
            const char* a1 = cA + (size_t)(t + 1) * kstep;
            const char* a2 = last ? nA : cA + (size_t)(t + 2) * kstep; const char* b2 = last ? nB : cB + (size_t)(t + 2) * kstep;
            const char* a3 = a2 + kstep; const char* b3 = b2 + kstep;
            PG8_LDB(B0, 0, 0); PG8_LDB(B1, 0, 1); PG8_SCHED; PG8_LDA(At, 0, 0); PG8_STAGE(PG8_SA(1, 1), a1 + hstepA, voffA);
            PG8_WAIT_V(8); PG8_WAIT_L(0); PG8_BAR; PG8_MMA(0, 0, At, B0); PG8_MMA(0, 1, At, B1); PG8_BAR; PG8_SCHED;
            PG8_LDA(At, 0, 1); PG8_STAGE(PG8_SB(0, 0), b2, voffB); PG8_STAGE(PG8_SB(0, 1), b2 + hstep, voffB); PG8_STAGE(PG8_SA(0, 0), a2, voffA);
            PG8_WAIT_V(8); PG8_WAIT_L(0); PG8_BAR; PG8_MMA(1, 0, At, B0); PG8_MMA(1, 1, At, B1); PG8_BAR; PG8_SCHED;
            PG8_LDB(B0, 1, 0); PG8_LDB(B1, 1, 1); PG8_SCHED; PG8_LDA(At, 1, 0); PG8_STAGE(PG8_SA(0, 1), a2 + hstepA, voffA);
            PG8_WAIT_V(8); PG8_WAIT_L(0); PG8_BAR; PG8_MMA(0, 0, At, B0); PG8_MMA(0, 1, At, B1); PG8_BAR; PG8_SCHED;
            PG8_LDA(At, 1, 1); PG8_STAGE(PG8_SB(1, 0), b3, voffB); PG8_STAGE(PG8_SB(1, 1), b3 + hstep, voffB); PG8_STAGE(PG8_SA(1, 0), a3, voffA);
            PG8_WAIT_V(8); PG8_WAIT_L(0); PG8_BAR; PG8_MMA(1, 0, At, B0); PG8_MMA(1, 1, At, B1); PG8_BAR; PG8_SCHED;
        }
        if (wr == 0) PG8_BAR;
        E(acc, cur, wr, wc, fr, fq);
        if (!has_next) break;
#pragma unroll
        for (int a = 0; a < 2; ++a)
#pragma unroll
            for (int b = 0; b < 2; ++b)
#pragma unroll
                for (int m = 0; m < 4; ++m)
#pragma unroll
                    for (int n = 0; n < 2; ++n) acc[a][b][m][n] = (f32x4){0.f, 0.f, 0.f, 0.f};
        cur = nxt; cA = nA; cB = nB; ++ui;
        if (wr == 1) PG8_BAR;
    }
    PG8_WAIT_V(0);
    PG8_BAR;
#undef PG8_SA
#undef PG8_SB
#undef PG8_STAGE
#undef PG8_LDA
#undef PG8_LDB
#undef PG8_MMA
#undef PG8_WAIT_V
#undef PG8_WAIT_L
#undef PG8_BAR
#undef PG8_SCHED
}
}

enum { EPI_PLAIN = 0, EPI_RELU2 = 1, EPI_LORA1 = 2, EPI_LORA2 = 3 };
enum { SUB_PLAIN = 0, SUB_RELU2 = 1, SUB_TANH = 2, SUB_SIGM = 3, SUB_EW = 4, SUB_SIGB = 5 };
template <int SUB>
__device__ __forceinline__ void epi_half(const f32x4 (&acc)[2][2][4][2], int bj, bf16_t* dst0  , size_t ldc, const float* bias  ) {
    f32x4 b0 = {0.f, 0.f, 0.f, 0.f}, b1 = {0.f, 0.f, 0.f, 0.f};
    if (SUB == SUB_EW || SUB == SUB_SIGB) { b0 = *(const f32x4*)bias; b1 = *(const f32x4*)(bias + 4); }
#pragma unroll
    for (int ai = 0; ai < 2; ++ai)
#pragma unroll
        for (int m = 0; m < 4; ++m) {
            const f32x4 v0 = acc[ai][bj][m][0] + b0, v1 = acc[ai][bj][m][1] + b1;
            float v[8] = {v0[0], v0[1], v0[2], v0[3], v1[0], v1[1], v1[2], v1[3]};
#pragma unroll
            for (int j = 0; j < 8; ++j) {
                if (SUB == SUB_RELU2) { const float t = fmaxf(v[j], 0.f); v[j] = t * t; }
                else if (SUB == SUB_TANH) v[j] = 1.f - 2.f / (1.f + __expf(2.f * v[j]));
                else if (SUB == SUB_SIGM || SUB == SUB_SIGB) v[j] = sigmoidf_(v[j]);
                else if (SUB == SUB_EW) { const float x = -v[j]; const float sp = fmaxf(x, 0.f) + __logf(1.f + __expf(-fabsf(x))); v[j] = __expf(-sp - 0.5f); }
            }
            u32x4 pk; pk[0] = cvt_pk_bf16(v[0], v[1]); pk[1] = cvt_pk_bf16(v[2], v[3]); pk[2] = cvt_pk_bf16(v[4], v[5]); pk[3] = cvt_pk_bf16(v[6], v[7]);
            *(u32x4*)(dst0 + (size_t)(ai * 128 + m * 16) * ldc) = pk;
        }
}
template <int MODE> struct Epi {
    static constexpr bool PERM = true;
    bf16_t* O; int ldc; bf16_t* O2; const float* const* tbl;
    __device__ __forceinline__ void operator()(const f32x4 (&acc)[2][2][4][2], const pg8::Unit& u, int, int, int, int) const {
        const int t = opaque_tid(), lane = t & 63, wid = t >> 6, wr = wid >> 2, wc = wid & 3, fr = lane & 15, fq = lane >> 4;
        const size_t row0 = (size_t)(u.pm * 256 + wr * 64 + fr); const int col0 = u.pn * 256 + wc * 32 + 8 * fq;
        if (MODE == EPI_PLAIN) { epi_half<SUB_PLAIN>(acc, 0, O + row0 * ldc + col0, ldc, nullptr); epi_half<SUB_PLAIN>(acc, 1, O + row0 * ldc + col0 + 128, ldc, nullptr); }
        else if (MODE == EPI_RELU2) { epi_half<SUB_RELU2>(acc, 0, O + row0 * ldc + col0, ldc, nullptr); epi_half<SUB_RELU2>(acc, 1, O + row0 * ldc + col0 + 128, ldc, nullptr); }
        else if (MODE == EPI_LORA1) {
            if (u.pn == 0) { epi_half<SUB_TANH>(acc, 0, O + row0 * 384 + col0, 384, nullptr); epi_half<SUB_PLAIN>(acc, 1, O + row0 * 384 + col0 + 128, 384, nullptr); }
            else epi_half<SUB_SIGM>(acc, 0, O + row0 * 384 + col0, 384, nullptr);
        } else {
            const int seg = u.pn >> 3;
            if (seg == 0) { const float* p0 = tbl[31]; epi_half<SUB_EW>(acc, 0, O + row0 * 4096 + col0, 4096, p0 + col0); epi_half<SUB_EW>(acc, 1, O + row0 * 4096 + col0 + 128, 4096, p0 + col0 + 128); }
            else if (seg == 1) { const float* p1 = tbl[34]; epi_half<SUB_SIGB>(acc, 0, O + row0 * 4096 + col0, 4096, p1 + col0 - 2048); epi_half<SUB_SIGB>(acc, 1, O + row0 * 4096 + col0 + 128, 4096, p1 + col0 - 2048 + 128); }
            else { epi_half<SUB_PLAIN>(acc, 0, O2 + row0 * 1024 + col0 - 4096, 1024, nullptr); epi_half<SUB_PLAIN>(acc, 1, O2 + row0 * 1024 + col0 - 4096 + 128, 1024, nullptr); }
        }
    }
};
template <int MODE>
__device__ __forceinline__ void run_gemm(unsigned char* shm, const bf16_t* A, const bf16_t* Bt, int M, int N, int K, bf16_t* O, int ldc, bf16_t* O2 = nullptr, const float* const* tbl = nullptr, int lda = 0) {
    if (lda == 0) lda = K;
    asm volatile("" : "+s"(M), "+s"(N), "+s"(K), "+s"(lda));
    pg8::Gemm g{A, Bt, M, N, K, lda}; pg8::StaticOrder S; S.init(M, N, (int)gridDim.x, opaque_bid());
    Epi<MODE> E{O, ldc, O2, tbl};
    pg8::gemm_phase<Epi<MODE>, pg8::StaticOrder>((LAS unsigned char*)shm, g, S, E);
}

__device__ __forceinline__ void transpose_w(unsigned char* shm, const float* __restrict__ src, bf16_t* __restrict__ dst, int K, int N) {
    const int TIX = opaque_tid(); const int BIX = opaque_bid(); (void)TIX; (void)BIX;
    const int lane = TIX & 63, w = TIX >> 6;
    bf16_t* tl = (bf16_t*)(shm + w * 13312);
    const int ntn = N / 64, ntiles = (K / 64) * ntn;
    for (int tile = BIX * 8 + w; tile < ntiles; tile += gridDim.x * 8) {
        const int k0 = (tile / ntn) * 64, n0 = (tile % ntn) * 64;
        f32x4 v[16];
#pragma unroll
        for (int i = 0; i < 16; ++i) { const int kk = i * 4 + (lane >> 4), n4 = (lane & 15) * 4; v[i] = *(const f32x4*)(src + (size_t)(k0 + kk) * N + n0 + n4); }
#pragma unroll
        for (int i = 0; i < 16; ++i) { const int kk = i * 4 + (lane >> 4), n4 = (lane & 15) * 4;
            tl[(n4 + 0) * 72 + kk] = f2bf(v[i][0]); tl[(n4 + 1) * 72 + kk] = f2bf(v[i][1]); tl[(n4 + 2) * 72 + kk] = f2bf(v[i][2]); tl[(n4 + 3) * 72 + kk] = f2bf(v[i][3]); }
        WAVE_SYNC();
#pragma unroll
        for (int i = 0; i < 8; ++i) { const int n = i * 8 + (lane >> 3), k8 = (lane & 7) * 8;
            const u32x4 o = *(const u32x4*)(tl + n * 72 + k8);
            *(u32x4*)(dst + (size_t)(n0 + n) * K + k0 + k8) = o; }
        WAVE_SYNC();
    }
}

__device__ __forceinline__ void prologue(const Params& P, unsigned char* shm) {
    const int TIX = opaque_tid(); const int BIX = opaque_bid(); (void)TIX; (void)BIX;
    unsigned char* ws = P.ws;
    const int tid = TIX;
    const size_t gtid = (size_t)BIX * 512 + tid, gsz = (size_t)gridDim.x * 512;
    transpose_w(shm, P.in[10], (bf16_t*)(ws + WB_WINE), 2048, 4096);
    transpose_w(shm, P.in[11], (bf16_t*)(ws + WB_WINO), 2048, 6144);
    transpose_w(shm, P.in[12], (bf16_t*)(ws + WB_WOUT0), 2048, 2048);
    transpose_w(shm, P.in[12] + (size_t)2048 * 2048, (bf16_t*)(ws + WB_WOUT1), 2048, 2048);
    transpose_w(shm, P.in[13], (bf16_t*)(ws + WB_W1_0), 2048, 8192);
    transpose_w(shm, P.in[13] + (size_t)2048 * 8192, (bf16_t*)(ws + WB_W1_1), 2048, 8192);
    transpose_w(shm, P.in[14], (bf16_t*)(ws + WB_W2_0), 8192, 2048);
    transpose_w(shm, P.in[14] + (size_t)2048 * 8192, (bf16_t*)(ws + WB_W2_1), 8192, 2048);
    {   const float* mu = P.in[30]; const float* w1 = P.in[32]; const float* a1 = P.in[35]; const float* g1 = P.in[37];
        bf16_t* L1T = (bf16_t*)(ws + OFF_L1T);
        for (size_t i = gtid; i < (size_t)768 * 1024; i += gsz) {
            const int n = (int)(i >> 10), kk = (int)(i & 1023), nn = n < 384 ? n : n - 384; const bool hi = n >= 384;
            float sv = 0.f, m = 1.f;
            if (nn < 64) { sv = w1[(size_t)(kk) * 64 + nn]; m = mu[3 * 1024 + kk]; }
            else if (nn < 128) { sv = w1[(size_t)(1024 + kk) * 64 + (nn - 64)]; m = mu[3 * 1024 + kk]; }
            else if (nn < 192) { sv = a1[(size_t)(kk) * 64 + (nn - 128)]; m = mu[4 * 1024 + kk]; }
            else if (nn < 256) { sv = a1[(size_t)(1024 + kk) * 64 + (nn - 192)]; m = mu[4 * 1024 + kk]; }
            else { sv = g1[(size_t)kk * 128 + (nn - 256)]; m = mu[5 * 1024 + kk]; }
            L1T[i] = f2bf(hi ? m * sv : sv);
        }
        const float* w2 = P.in[33]; const float* a2 = P.in[36]; const float* g2 = P.in[38];
        bf16_t* L2T = (bf16_t*)(ws + OFF_L2T);
        for (size_t i = gtid; i < (size_t)5120 * 384; i += gsz) {
            const int n = (int)(i / 384), k = (int)(i % 384), seg = n >> 10, c = n & 1023;
            float s = 0.f;
            if (seg == 0 && k < 64) s = w2[(size_t)k * 1024 + c];
            else if (seg == 1 && k >= 64 && k < 128) s = w2[(size_t)(64 + k - 64) * 1024 + c];
            else if (seg == 2 && k >= 128 && k < 192) s = a2[(size_t)(k - 128) * 1024 + c];
            else if (seg == 3 && k >= 192 && k < 256) s = a2[(size_t)(64 + k - 192) * 1024 + c];
            else if (seg == 4 && k >= 256) s = g2[(size_t)(k - 256) * 1024 + c];
            L2T[i] = f2bf(s);
        }
        const float* sw = P.in[28]; bf16_t* WSB = (bf16_t*)(ws + OFF_WSB);
        for (size_t i = gtid; i < (size_t)8 * 128 * 128; i += gsz) WSB[i] = f2bf(sw[i]);
    }
    {   float* act = (float*)shm;
        float* red = (float*)(shm + 40960);
        __syncthreads();
        for (int i = tid; i < 5 * 2048; i += 512) { const int bi = i >> 11, k = i & 2047; const float c = bi < 4 ? P.in[1][bi * 2048 + k] : P.in[3][k]; act[i] = c / (1.f + __expf(-c)); }
        __syncthreads();
        float* MOD = (float*)(ws + OFF_MOD);
        const int kq = tid >> 6, col = tid & 63;
        for (int unit = BIX; unit < 2 * 192; unit += gridDim.x) {
            const int l = unit / 192, n0 = (unit % 192) * 64;
            const float* w = P.in[4] + (size_t)l * 2048 * 12288 + n0 + col;
            float a0 = 0.f, a1 = 0.f, a2 = 0.f, a3 = 0.f, a4 = 0.f;
#pragma unroll 8
            for (int k = kq * 256; k < kq * 256 + 256; ++k) { const float wv = w[(size_t)k * 12288];
                a0 += act[k] * wv; a1 += act[2048 + k] * wv; a2 += act[4096 + k] * wv; a3 += act[6144 + k] * wv; a4 += act[8192 + k] * wv; }
            red[(kq * 5 + 0) * 64 + col] = a0; red[(kq * 5 + 1) * 64 + col] = a1; red[(kq * 5 + 2) * 64 + col] = a2; red[(kq * 5 + 3) * 64 + col] = a3; red[(kq * 5 + 4) * 64 + col] = a4;
            __syncthreads();
            if (tid < 320) { const int bi = tid >> 6, cc = tid & 63; float s = P.in[5][l * 12288 + n0 + cc];
#pragma unroll
                for (int q = 0; q < 8; ++q) s += red[(q * 5 + bi) * 64 + cc];
                MOD[((size_t)l * 5 + bi) * 12288 + n0 + cc] = s; }
            __syncthreads();
        }
    }
}

__device__ __forceinline__ void resid_mod(const PP& P, int nrows, const float* xin_lat, const float* xin_ctx, float* xout_lat, float* xout_ctx,
                          const bf16_t* y, const float* gpost, int gate_off, int layer_g, int layer_m, const float* gpre, int sh_off, int sc_off, bf16_t* hn) {
    const int TIX = opaque_tid(); const int BIX = opaque_bid(); (void)TIX; (void)BIX;
    const float* MODG = (const float*)(P.ws + OFF_MOD) + (size_t)layer_g * 5 * 12288;
    const float* MODM = (const float*)(P.ws + OFF_MOD) + (size_t)layer_m * 5 * 12288;
    const int lane = TIX & 63, gw = BIX * 8 + (TIX >> 6), nw = gridDim.x * 8;
    for (int pr = gw; pr < nrows / 2; pr += nw) {
        const int row = 2 * pr;
        const bool isl = row < TL; const int bi = isl ? (row >> 13) : 4;
        const float* xi = isl ? xin_lat + (size_t)row * DM : xin_ctx + (size_t)(row - TL) * DM;
        const float* modg = MODG + (size_t)bi * 12288; const float* mod = MODM + (size_t)bi * 12288;
        f32x4 x[2][8];
#pragma unroll
        for (int q = 0; q < 2; ++q)
#pragma unroll
            for (int j = 0; j < 8; ++j) x[q][j] = *(const f32x4*)(xi + (size_t)q * DM + j * 256 + lane * 4);
        if (y) {
            u32x2 yr[2][8]; float ss0 = 0.f, ss1 = 0.f;
#pragma unroll
            for (int q = 0; q < 2; ++q)
#pragma unroll
                for (int j = 0; j < 8; ++j) yr[q][j] = *(const u32x2*)(y + (size_t)(row + q) * DM + j * 256 + lane * 4);
#pragma unroll
            for (int j = 0; j < 8; ++j) {
                const float a0 = bflo(yr[0][j][0]), a1 = bfhi(yr[0][j][0]), a2 = bflo(yr[0][j][1]), a3 = bfhi(yr[0][j][1]); ss0 += a0 * a0 + a1 * a1 + a2 * a2 + a3 * a3;
                const float b0 = bflo(yr[1][j][0]), b1 = bfhi(yr[1][j][0]), b2 = bflo(yr[1][j][1]), b3 = bfhi(yr[1][j][1]); ss1 += b0 * b0 + b1 * b1 + b2 * b2 + b3 * b3; }
            ss0 = wave_sum(ss0); ss1 = wave_sum(ss1);
            const float rs0 = rsqrtf(ss0 * (1.f / 2048.f) + 1e-6f), rs1 = rsqrtf(ss1 * (1.f / 2048.f) + 1e-6f);
#pragma unroll
            for (int j = 0; j < 8; ++j) { const int c = j * 256 + lane * 4; const f32x4 gp = *(const f32x4*)(gpost + c); const f32x4 gt = *(const f32x4*)(modg + gate_off + c);
                const f32x4 ggp = gt * gp;
                const f32x4 y0 = {bflo(yr[0][j][0]), bfhi(yr[0][j][0]), bflo(yr[0][j][1]), bfhi(yr[0][j][1])}, y1 = {bflo(yr[1][j][0]), bfhi(yr[1][j][0]), bflo(yr[1][j][1]), bfhi(yr[1][j][1])};
                x[0][j] += ggp * (y0 * rs0); x[1][j] += ggp * (y1 * rs1); }
        }
        if (xout_lat) { float* xo = isl ? xout_lat + (size_t)row * DM : xout_ctx + (size_t)(row - TL) * DM;
#pragma unroll
            for (int q = 0; q < 2; ++q)
#pragma unroll
                for (int j = 0; j < 8; ++j) *(f32x4*)(xo + (size_t)q * DM + j * 256 + lane * 4) = x[q][j]; }
        if (hn) {
            float ss0 = 0.f, ss1 = 0.f;
#pragma unroll
            for (int j = 0; j < 8; ++j) { ss0 += x[0][j][0] * x[0][j][0] + x[0][j][1] * x[0][j][1] + x[0][j][2] * x[0][j][2] + x[0][j][3] * x[0][j][3];
                ss1 += x[1][j][0] * x[1][j][0] + x[1][j][1] * x[1][j][1] + x[1][j][2] * x[1][j][2] + x[1][j][3] * x[1][j][3]; }
            ss0 = wave_sum(ss0); ss1 = wave_sum(ss1);
            const float rs0 = rsqrtf(ss0 * (1.f / 2048.f) + 1e-6f), rs1 = rsqrtf(ss1 * (1.f / 2048.f) + 1e-6f);
#pragma unroll
            for (int j = 0; j < 8; ++j) { const int c = j * 256 + lane * 4; const f32x4 g = *(const f32x4*)(gpre + c); const f32x4 sh = *(const f32x4*)(mod + sh_off + c); const f32x4 sc = *(const f32x4*)(mod + sc_off + c);
                const f32x4 gs = g * (sc + 1.f);
                const f32x4 h0 = (x[0][j] * rs0) * gs + sh, h1 = (x[1][j] * rs1) * gs + sh;
                u32x2 p0, p1; p0[0] = cvt_pk_bf16(h0[0], h0[1]); p0[1] = cvt_pk_bf16(h0[2], h0[3]); p1[0] = cvt_pk_bf16(h1[0], h1[1]); p1[1] = cvt_pk_bf16(h1[2], h1[3]);
                *(u32x2*)(hn + (size_t)row * DM + c) = p0; *(u32x2*)(hn + (size_t)(row + 1) * DM + c) = p1; }
        }
    }
}

template <bool FINAL>
__device__ __forceinline__ void s5_task(const PP& P, int task, unsigned char* wl, const bf16_t* z, float2* E, bf16_t* o) {
    const int TIX = opaque_tid(); const int BIX = opaque_bid(); (void)TIX; (void)BIX;
    const int lane = TIX & 63, fr = lane & 15, fq = lane >> 4;
    const int c = task % 132, bg = task / 132, g = bg & 63, b = bg >> 6;
    const bool isctx = c >= 128; const int t0 = isctx ? (c - 128) * 64 : c * 64;
    const size_t rowbase = isctx ? (size_t)TL + b * 256 + t0 : (size_t)b * 8192 + t0;
    float* buL = (float*)wl;
    bf16_t* xL = (bf16_t*)(wl + 8448);
    bf16_t* gL = (bf16_t*)wl;
    const float* a_re = P.in[15]; const float* a_im = P.in[16]; const float* log_dt = P.in[17];
    const float* b_re = P.in[18]; const float* b_im = P.in[19]; const float* c_re = P.in[20]; const float* c_im = P.in[21];
    f32x4 yacc[4];
    bf16x8 Uall[4];
#pragma unroll
    for (int i = 0; i < 4; ++i) { yacc[i] = (f32x4){0.f, 0.f, 0.f, 0.f}; Uall[i] = zero8(); if (fq < 2) Uall[i] = *(const bf16x8*)(z + (rowbase + i * 16 + fr) * 4096 + g * 16 + fq * 8); }
    if (FINAL) {
        float dv[8];
#pragma unroll
        for (int j = 0; j < 8; ++j) dv[j] = (fq < 2 && fq * 8 + j == fr) ? P.in[22][g * 16 + fr] : 0.f;
        const bf16x8 Dm = pack8(dv);
#pragma unroll
        for (int i = 0; i < 4; ++i) yacc[i] = MFMA16(Uall[i], Dm, yacc[i]);
    }
    for (int dir = 0; dir < 2; ++dir) {
        const int dg = dir * 64 + g;
        const float dt = __expf(log_dt[dg]);
        float lre, lim;
        lam_bar_of(a_re[dg * 64 + lane], a_im[dg * 64 + lane], dt, lre, lim);
        bf16x8 Bm[8];
#pragma unroll
        for (int q = 0; q < 4; ++q) {
            const int n = q * 16 + fr;
            const float are = a_re[dg * 64 + n], aim = a_im[dg * 64 + n]; float l_re, l_im; lam_bar_of(are, aim, dt, l_re, l_im);
            const float nr = l_re - 1.f, ni = l_im, den = 1.f / (are * are + aim * aim);
            const float cre = (nr * are + ni * aim) * den, cim = (ni * are - nr * aim) * den;
            if (fq < 2) {
                const float* pr = b_re + ((size_t)dg * 64 + n) * 16 + fq * 8; const float* pi = b_im + ((size_t)dg * 64 + n) * 16 + fq * 8;
                const f32x4 r0 = *(const f32x4*)pr, r1 = *(const f32x4*)(pr + 4), i0 = *(const f32x4*)pi, i1 = *(const f32x4*)(pi + 4);
                Bm[q] = pack8v(r0 * cre - i0 * cim, r1 * cre - i1 * cim);
                Bm[q + 4] = pack8v(i0 * cre + r0 * cim, i1 * cre + r1 * cim);
            } else { Bm[q] = zero8(); Bm[q + 4] = zero8(); }
        }
        bf16x8 Cm[4];
        if (FINAL) {
#pragma unroll
            for (int kk = 0; kk < 4; ++kk) {
                const int k = kk * 32 + fq * 8;
                if (k < 64) { const float* pc = c_re + ((size_t)dg * 16 + fr) * 64 + k; Cm[kk] = pack8v(*(const f32x4*)pc, *(const f32x4*)(pc + 4)); }
                else { const float* pc = c_im + ((size_t)dg * 16 + fr) * 64 + (k - 64); Cm[kk] = pack8v(-*(const f32x4*)pc, -*(const f32x4*)(pc + 4)); }
            }
        }
        const int ci = dir == 0 ? (isctx ? (c - 128) : 4 + c) : (isctx ? 3 - (c - 128) : 4 + (127 - c));
        const size_t eidx = ((((size_t)dir * 4 + b) * 64 + g) * 132 + ci) * 64 + lane;
        float xr = 0.f, xi = 0.f;
        if (FINAL) { const float2 e = E[eidx]; xr = e.x; xi = e.y; }
#pragma unroll
        for (int mi = 0; mi < 4; ++mi) {
            const int mt = dir == 0 ? mi : 3 - mi;
            const bf16x8 Ua = dir == 0 ? Uall[mi] : Uall[3 - mi];
#pragma unroll
            for (int nt = 0; nt < 8; ++nt) {
                f32x4 d = {0.f, 0.f, 0.f, 0.f};
                asm volatile("" : "+v"(d));
                d = MFMA16(Ua, Bm[nt], d);
                asm volatile("" :: "v"(Ua));
#pragma unroll
                for (int i = 0; i < 4; ++i) buL[(fq * 4 + i) * 132 + nt * 16 + fr] = d[i];
            }
            WAVE_SYNC();
#pragma unroll
            for (int s = 0; s < 16; ++s) {
                const int tl = dir == 0 ? s : 15 - s;
                const float br = buL[tl * 132 + lane], bi = buL[tl * 132 + 64 + lane];
                const float nr = lre * xr - lim * xi + br, ni = lre * xi + lim * xr + bi; xr = nr; xi = ni;
                if (FINAL) { xL[tl * 144 + lane] = f2bf(xr); xL[tl * 144 + 64 + lane] = f2bf(xi); }
            }
            WAVE_SYNC();
            if (FINAL) {
                f32x4 ya = dir == 0 ? yacc[mi] : yacc[3 - mi];
#pragma unroll
                for (int kk = 0; kk < 4; ++kk) { const bf16x8 Xa = *(const bf16x8*)(xL + fr * 144 + kk * 32 + fq * 8); ya = MFMA16(Xa, Cm[kk], ya); }
                if (dir == 0) yacc[mi] = ya; else yacc[3 - mi] = ya;
                WAVE_SYNC();
            }
        }
        if (!FINAL) E[eidx] = make_float2(xr, xi);
    }
    if (FINAL) {
        const float* glw = P.in[23]; const float* glb = P.in[24];
#pragma unroll
        for (int mt = 0; mt < 4; ++mt)
#pragma unroll
            for (int i = 0; i < 4; ++i) { const int t = mt * 16 + fq * 4 + i;
                gL[t * 32 + fr] = f2bf(gelu_tanh(yacc[mt][i])); }
        WAVE_SYNC();
        bf16x8 Wv = zero8(), Wg = zero8();
        if (fq < 2) { float wv[8], wg[8];
#pragma unroll
            for (int j = 0; j < 8; ++j) { const int p = fq * 8 + j; wv[j] = glw[((size_t)g * 16 + p) * 16 + fr]; wg[j] = glw[((size_t)(64 + g) * 16 + p) * 16 + fr]; }
            Wv = pack8(wv); Wg = pack8(wg); }
        const float bv = glb[g * 16 + fr], bgt = glb[(64 + g) * 16 + fr];
#pragma unroll
        for (int mt = 0; mt < 4; ++mt) {
            bf16x8 Ga = zero8();
            if (fq < 2) Ga = *(const bf16x8*)(gL + (mt * 16 + fr) * 32 + fq * 8);
            f32x4 val = {0.f, 0.f, 0.f, 0.f}, gt = {0.f, 0.f, 0.f, 0.f};
            asm volatile("" : "+v"(val), "+v"(gt));
            val = MFMA16(Ga, Wv, val); gt = MFMA16(Ga, Wg, gt);
            asm volatile("" :: "v"(Ga));
#pragma unroll
            for (int i = 0; i < 4; ++i) { const int t = mt * 16 + fq * 4 + i;
                o[(rowbase + t) * 2048 + g * 16 + fr] = f2bf((val[i] + bv) * sigmoidf_(gt[i] + bgt)); }
        }
        WAVE_SYNC();
    }
}

__device__ __forceinline__ void s5_carry(const PP& P, float2* E) {
    const int TIX = opaque_tid(); const int BIX = opaque_bid(); (void)TIX; (void)BIX;
    const int gt = BIX * 512 + TIX;
    if (gt >= 2 * 4 * 64 * 64) return;
    const int n = gt & 63, g = (gt >> 6) & 63, b = (gt >> 12) & 3, dir = gt >> 14;
    const int dg = dir * 64 + g;
    const float dt = __expf(P.in[17][dg]);
    float pr, pi; lam_bar_of(P.in[15][dg * 64 + n], P.in[16][dg * 64 + n], dt, pr, pi);
#pragma unroll
    for (int i = 0; i < 6; ++i) { const float r = pr * pr - pi * pi, im = 2.f * pr * pi; pr = r; pi = im; }
    float sr = 0.f, si = 0.f;
    float2* e = E + ((((size_t)dir * 4 + b) * 64 + g) * 132) * 64 + n;
    for (int ci = 0; ci < 132; ++ci) { const float2 v = e[(size_t)ci * 64]; e[(size_t)ci * 64] = make_float2(sr, si);
        const float nr = pr * sr - pi * si + v.x, ni = pr * si + pi * sr + v.y; sr = nr; si = ni; }
}

__device__ __forceinline__ void vt_task(int task, unsigned char* wl, const bf16_t* z, bf16_t* VT, bf16_t* VCT) {
    const int TIX = opaque_tid(); const int BIX = opaque_bid(); (void)TIX; (void)BIX;
    const int lane = TIX & 63, tile = task >> 4, h = task & 15; const size_t row0 = (size_t)tile * 64;
    bf16_t* tl = (bf16_t*)wl;
#pragma unroll
    for (int i = 0; i < 8; ++i) { const int tok = i * 8 + (lane >> 3), d0 = (lane & 7) * 8;
        const u32x4 v = *(const u32x4*)(z + (row0 + tok) * 4096 + 3072 + h * 64 + d0);
#pragma unroll
        for (int j = 0; j < 4; ++j) { tl[(d0 + 2 * j) * 72 + tok] = (bf16_t)(v[j] & 0xffffu); tl[(d0 + 2 * j + 1) * 72 + tok] = (bf16_t)(v[j] >> 16); } }
    WAVE_SYNC();
    bf16_t* base; int ld;
    if (row0 < (size_t)TL) { const int b = (int)(row0 >> 13), tok0 = (int)(row0 & 8191); base = VT + ((size_t)(b * 16 + h) * 64) * 8192 + tok0; ld = 8192; }
    else { const int rr = (int)(row0 - TL), b = rr >> 8, tok0 = rr & 255; base = VCT + ((size_t)(b * 16 + h) * 64) * 256 + tok0; ld = 256; }
#pragma unroll
    for (int i = 0; i < 8; ++i) { const int d = i * 8 + (lane >> 3), t8 = (lane & 7) * 8;
        const u32x4 v = *(const u32x4*)(tl + d * 72 + t8); *(u32x4*)(base + (size_t)d * ld + t8) = v; }
    WAVE_SYNC();
}

template <bool BAND>
__device__ __forceinline__ void attn_task(const PP& P, int task, unsigned char* wl, const bf16_t* z, const bf16_t* VT, const bf16_t* VCT, bf16_t* o, const bf16_t* KL = nullptr, const bf16_t* VL = nullptr) {
    const int TIX = opaque_tid(); const int BIX = opaque_bid(); (void)TIX; (void)BIX;
    const int lane = TIX & 63, fr = lane & 15, fq = lane >> 4;
    int b, h, r = 0, qt; size_t qrow0;
    if (BAND) { qt = task & 3; r = (task >> 2) & 127; h = (task >> 9) & 15; b = task >> 13; qrow0 = (size_t)b * 8192 + r * 64 + qt * 16; }
    else { qt = task & 15; h = (task >> 4) & 15; b = task >> 8; qrow0 = (size_t)TL + b * 256 + qt * 16; }
    const int start = min(max(r - 4, 0), 120), wsq = min(max(qt * 16 - 8, 0), 32);
    bf16_t* pL = (bf16_t*)wl;
    const float* rpb = P.in[25];
    bf16x8 Qa[2];
    Qa[0] = *(const bf16x8*)(z + (qrow0 + fr) * 4096 + 1024 + h * 64 + fq * 8);
    Qa[1] = *(const bf16x8*)(z + (qrow0 + fr) * 4096 + 1024 + h * 64 + 32 + fq * 8);
    constexpr int NP0 = BAND ? 0 : 4;
    float mx[4] = {-1e30f, -1e30f, -1e30f, -1e30f}, ls[4] = {0.f, 0.f, 0.f, 0.f};
    f32x4 O[4];
#pragma unroll
    for (int i = 0; i < 4; ++i) O[i] = (f32x4){0.f, 0.f, 0.f, 0.f};
    bf16x8 Kc[4][2];
#define ATT_LOADK(dst, pc) do { _Pragma("unroll") for (int ntl = 0; ntl < 4; ++ntl) { const int nt_ = (pc) * 4 + ntl; size_t krow_; \
        if ((pc) < 4) krow_ = (size_t)b * 8192 + (start + (nt_ >> 1)) * 64 + wsq + (nt_ & 1) * 16 + fr; else krow_ = (size_t)TL + b * 256 + (nt_ - 16) * 16 + fr; \
        const bf16_t* kp_ = ((pc) >= 4 && KL) ? KL + ((nt_ - 16) * 16 + fr) * 72 + fq * 8 : z + krow_ * 4096 + 2048 + h * 64 + fq * 8; dst[ntl][0] = *(const bf16x8*)kp_; dst[ntl][1] = *(const bf16x8*)(kp_ + 32); } } while (0)
    ATT_LOADK(Kc, NP0);
#pragma unroll 1
    for (int piece = NP0; piece < 8; ++piece) {
        const bool band = piece < 4;
        bf16x8 Vc[2][4];
#pragma unroll
        for (int kk = 0; kk < 2; ++kk) {
            const int kg = piece * 2 + kk;
#pragma unroll
            for (int dt = 0; dt < 4; ++dt) {
                const int d = dt * 16 + fr; const bf16_t* vp;
                if (band) vp = VT + ((size_t)(b * 16 + h) * 64 + d) * 8192 + (start + kg) * 64 + wsq + fq * 8;
                else if (VL) vp = VL + d * 264 + (kg - 8) * 32 + fq * 8;
                else vp = VCT + ((size_t)(b * 16 + h) * 64 + d) * 256 + (kg - 8) * 32 + fq * 8;
                Vc[kk][dt] = *(const bf16x8*)vp;
            }
        }
        float bias[4][4];
#pragma unroll
        for (int ntl = 0; ntl < 4; ++ntl)
#pragma unroll
            for (int i = 0; i < 4; ++i) {
                bias[ntl][i] = 0.f;
                if (BAND && band) {
                    const int nt = piece * 4 + ntl;
                    const int kcol = wsq + (nt & 1) * 16 + fr, qcol = qt * 16 + fq * 4 + i;
                    const int dr = start + (nt >> 1) - r + 7, dc = min(max(kcol - qcol + 15, 0), 30);
                    bias[ntl][i] = rpb[(h * 15 + dr) * 31 + dc];
                }
            }
        bf16x8 Kn[4][2];
#pragma unroll
        for (int ntl = 0; ntl < 4; ++ntl) { Kn[ntl][0] = Kc[ntl][0]; Kn[ntl][1] = Kc[ntl][1]; }
        if (piece + 1 < 8) ATT_LOADK(Kn, piece + 1);
        f32x4 S[4];
#pragma unroll
        for (int ntl = 0; ntl < 4; ++ntl) {
            f32x4 sacc = {0.f, 0.f, 0.f, 0.f};
            asm volatile("" : "+v"(sacc));
            sacc = MFMA16(Qa[0], Kc[ntl][0], sacc);
            sacc = MFMA16(Qa[1], Kc[ntl][1], sacc);
            S[ntl] = sacc;
        }
        if (BAND) asm volatile("" : "+v"(bias[0][0]), "+v"(bias[0][1]), "+v"(bias[0][2]), "+v"(bias[0][3]), "+v"(bias[1][0]), "+v"(bias[1][1]), "+v"(bias[1][2]), "+v"(bias[1][3]),
                                    "+v"(bias[2][0]), "+v"(bias[2][1]), "+v"(bias[2][2]), "+v"(bias[2][3]), "+v"(bias[3][0]), "+v"(bias[3][1]), "+v"(bias[3][2]), "+v"(bias[3][3]));
        float ml[4] = {-1e30f, -1e30f, -1e30f, -1e30f};
#pragma unroll
        for (int ntl = 0; ntl < 4; ++ntl)
#pragma unroll
            for (int i = 0; i < 4; ++i) {
                float sc = S[ntl][i] * 0.125f;
                if (BAND && band) {
                    const int nt = piece * 4 + ntl;
                    const int kcol = wsq + (nt & 1) * 16 + fr, qcol = qt * 16 + fq * 4 + i, cs = min(max(qcol - 8, 0), 48);
                    const bool valid = (kcol >= cs) && (kcol < cs + 16);
                    sc = valid ? sc + bias[ntl][i] : -1e30f;
                }
                S[ntl][i] = sc; ml[i] = fmaxf(ml[i], sc);
            }
        float al[4];
#pragma unroll
        for (int i = 0; i < 4; ++i) { const float mn = fmaxf(mx[i], max16(ml[i])); al[i] = __expf(mx[i] - mn); mx[i] = mn; ls[i] *= al[i]; }
#pragma unroll
        for (int ntl = 0; ntl < 4; ++ntl)
#pragma unroll
            for (int i = 0; i < 4; ++i) { const float p = __expf(S[ntl][i] - mx[i]); ls[i] += p; pL[(fq * 4 + i) * 80 + ntl * 16 + fr] = f2bf(p); }
#pragma unroll
        for (int dt = 0; dt < 4; ++dt)
#pragma unroll
            for (int i = 0; i < 4; ++i) O[dt][i] *= al[i];
        WAVE_SYNC();
#pragma unroll
        for (int kk = 0; kk < 2; ++kk) {
            const bf16x8 Pa = *(const bf16x8*)(pL + fr * 80 + kk * 32 + fq * 8);
#pragma unroll
            for (int dt = 0; dt < 4; ++dt) O[dt] = MFMA16(Pa, Vc[kk][dt], O[dt]);
        }
        WAVE_SYNC();
#pragma unroll
        for (int ntl = 0; ntl < 4; ++ntl) { Kc[ntl][0] = Kn[ntl][0]; Kc[ntl][1] = Kn[ntl][1]; }
    }
#undef ATT_LOADK
    float sm[4];
#pragma unroll
    for (int i = 0; i < 4; ++i) sm[i] = 1.f / sum16(ls[i]);
#pragma unroll
    for (int dt = 0; dt < 4; ++dt)
#pragma unroll
        for (int i = 0; i < 4; ++i) pL[(fq * 4 + i) * 80 + dt * 16 + fr] = f2bf(O[dt][i] * sm[i]);
    WAVE_SYNC();
#pragma unroll
    for (int k = 0; k < 2; ++k) { const int idx = lane + 64 * k, q = idx >> 3, c8 = (idx & 7) * 8;
        *(u32x4*)(o + (qrow0 + q) * 2048 + 1024 + h * 64 + c8) = *(const u32x4*)(pL + q * 80 + c8); }
    WAVE_SYNC();
}


__device__ __forceinline__ void attn_naive(const PP& P, int task, unsigned char* wl, const bf16_t* z, bf16_t* o, bool band) {
    const int lane = opaque_tid() & 63;
    float* pbuf = (float*)wl; int* kbuf = (int*)(wl + 2048);
    int b, h, r = 0, col; size_t qrow;
    if (band) { h = task & 15; const int tok = (task >> 4) & 8191; b = task >> 17; r = tok >> 6; col = tok & 63; qrow = (size_t)b * 8192 + tok; }
    else { h = task & 15; col = (task >> 4) & 255; b = task >> 12; qrow = (size_t)TL + b * 256 + col; }
    const int start = min(max(r - 4, 0), 120), cs = min(max(col - 8, 0), 48);
    float q[64];
#pragma unroll
    for (int e = 0; e < 64; e += 2) { const unsigned u = *(const unsigned*)(z + qrow * 4096 + 1024 + h * 64 + e); q[e] = bflo(u) * 0.125f; q[e + 1] = bfhi(u) * 0.125f; }
    float sc[6]; int kr[6]; float m = -1e30f;
#pragma unroll
    for (int kk = 0; kk < 6; ++kk) {
        float bias = 0.f; bool valid = true; size_t krow;
        if (kk < 2) { const int kidx = kk * 64 + lane, jr = kidx >> 4, jc = kidx & 15; krow = (size_t)b * 8192 + (start + jr) * 64 + cs + jc;
            const int bi = band ? (h * 15 + start + jr - r + 7) * 31 + (cs + jc - col + 15) : 0; bias = P.in[25][bi]; valid = band; }
        else krow = (size_t)TL + b * 256 + (kk - 2) * 64 + lane;
        float d = 0.f;
#pragma unroll
        for (int e = 0; e < 64; e += 8) { const u32x4 u = *(const u32x4*)(z + krow * 4096 + 2048 + h * 64 + e);
            d += q[e] * bflo(u[0]) + q[e + 1] * bfhi(u[0]) + q[e + 2] * bflo(u[1]) + q[e + 3] * bfhi(u[1]) + q[e + 4] * bflo(u[2]) + q[e + 5] * bfhi(u[2]) + q[e + 6] * bflo(u[3]) + q[e + 7] * bfhi(u[3]); }
        sc[kk] = valid ? d + bias : -1e30f; kr[kk] = (int)krow; m = fmaxf(m, sc[kk]);
    }
#pragma unroll
    for (int o2 = 32; o2 > 0; o2 >>= 1) m = fmaxf(m, __shfl_xor(m, o2));
    float l = 0.f;
#pragma unroll
    for (int kk = 0; kk < 6; ++kk) { const float p = __expf(sc[kk] - m); l += p; pbuf[kk * 64 + lane] = p; kbuf[kk * 64 + lane] = kr[kk]; }
    l = wave_sum(l);
    WAVE_SYNC();
    float acc = 0.f;
    for (int i = band ? 0 : 128; i < 384; ++i) acc += pbuf[i] * bf2f(z[(size_t)kbuf[i] * 4096 + 3072 + h * 64 + lane]);
    o[qrow * 2048 + 1024 + h * 64 + lane] = f2bf(acc / l);
    WAVE_SYNC();
}

__device__ __forceinline__ void sgu_pre(const PP& P, unsigned char* shm, const bf16_t* z, bf16_t* VLNT) {
    const int TIX = opaque_tid(); const int BIX = opaque_bid(); (void)TIX; (void)BIX;
    bf16_t* tl = (bf16_t*)shm;
    const int tid = TIX, lane = tid & 63, w = tid >> 6;
    const float* lg = P.in[26]; const float* lb = P.in[27];
    for (int bt = BIX; bt < TL / 32; bt += gridDim.x) {
        const size_t row0 = (size_t)bt * 32;
        for (int tk = 0; tk < 4; ++tk) {
            const int tokl = w * 4 + tk; const size_t row = row0 + tokl;
            float v[16]; float s = 0.f;
#pragma unroll
            for (int j = 0; j < 4; ++j) { const u32x2 r = *(const u32x2*)(z + row * 6144 + 1024 + j * 256 + lane * 4);
                v[j * 4 + 0] = gelu_tanh(bflo(r[0])); v[j * 4 + 1] = gelu_tanh(bfhi(r[0])); v[j * 4 + 2] = gelu_tanh(bflo(r[1])); v[j * 4 + 3] = gelu_tanh(bfhi(r[1]));
                s += v[j * 4] + v[j * 4 + 1] + v[j * 4 + 2] + v[j * 4 + 3]; }
            const float mean = wave_sum(s) * (1.f / 1024.f);
            float q = 0.f;
#pragma unroll
            for (int j = 0; j < 16; ++j) { v[j] -= mean; q += v[j] * v[j]; }
            const float rstd = rsqrtf(wave_sum(q) * (1.f / 1024.f) + 1e-5f);
#pragma unroll
            for (int j = 0; j < 4; ++j)
#pragma unroll
                for (int e = 0; e < 4; ++e) { const int ch = j * 256 + lane * 4 + e; tl[ch * 40 + tokl] = f2bf(v[j * 4 + e] * rstd * lg[ch] + lb[ch]); }
        }
        __syncthreads();
        const int b = (int)(row0 >> 13), tok0 = (int)(row0 & 8191);
#pragma unroll
        for (int i = 0; i < 8; ++i) { const int idx = i * 512 + tid, ch = idx >> 2, t8 = (idx & 3) * 8;
            const u32x4 vv = *(const u32x4*)(tl + ch * 40 + t8);
            *(u32x4*)(VLNT + ((size_t)b * 1024 + ch) * 8192 + tok0 + t8) = vv; }
        __syncthreads();
    }
}
__device__ __forceinline__ void sgu_task(const PP& P, int task, const bf16_t* z, const bf16_t* VLNT, const bf16_t* WSB, bf16_t* o) {
    const int TIX = opaque_tid(); const int BIX = opaque_bid(); (void)TIX; (void)BIX;
    const int lane = TIX & 63, fr = lane & 15, fq = lane >> 4;
    const int pq = task & 3, h = (task >> 2) & 7, n = (task >> 5) & 63, b = task >> 11;
    f32x4 acc[2][8];
#pragma unroll
    for (int m = 0; m < 2; ++m)
#pragma unroll
        for (int ct = 0; ct < 8; ++ct) acc[m][ct] = (f32x4){0.f, 0.f, 0.f, 0.f};
#pragma unroll
    for (int kk = 0; kk < 4; ++kk) {
        bf16x8 Aw[2];
#pragma unroll
        for (int m = 0; m < 2; ++m) Aw[m] = *(const bf16x8*)(WSB + ((size_t)h * 128 + pq * 32 + m * 16 + fr) * 128 + kk * 32 + fq * 8);
#pragma unroll
        for (int ct = 0; ct < 8; ++ct) {
            const bf16x8 Bv = *(const bf16x8*)(VLNT + ((size_t)b * 1024 + h * 128 + ct * 16 + fr) * 8192 + n * 128 + kk * 32 + fq * 8);
            acc[0][ct] = MFMA16(Aw[0], Bv, acc[0][ct]); acc[1][ct] = MFMA16(Aw[1], Bv, acc[1][ct]);
        }
    }
    const float* sb = P.in[29];
#pragma unroll
    for (int m = 0; m < 2; ++m)
#pragma unroll
        for (int i = 0; i < 4; ++i) {
            const int p = pq * 32 + m * 16 + fq * 4 + i; const float bias = sb[h * 128 + p];
            const size_t row = (size_t)b * 8192 + n * 128 + p;
#pragma unroll
            for (int ct = 0; ct < 8; ++ct) { const int c = h * 128 + ct * 16 + fr;
                const float u = gelu_tanh(bf2f(z[row * 6144 + c]));
                o[row * 2048 + c] = f2bf(u * (acc[m][ct][i] + bias)); }
        }
}

__device__ __forceinline__ void lora1_combine(const bf16_t* U, bf16_t* L1) {
    const int TIX = opaque_tid(); const int BIX = opaque_bid(); (void)TIX; (void)BIX;
    const size_t gtid = (size_t)BIX * 512 + TIX, gsz = (size_t)gridDim.x * 512;
    for (size_t i = gtid; i < (size_t)TT * 48; i += gsz) {
        const size_t row = i / 48; const int c = (int)(i % 48) * 8;
        int t, L; if (row < (size_t)TL) { t = (int)(row & 8191); L = 8192; } else { t = (int)((row - TL) & 255); L = 256; }
        const bf16_t* p = U + row * 768 + c;
        const u32x4 base = *(const u32x4*)p, cur = *(const u32x4*)(p + 384);
        u32x4 pv = {0u, 0u, 0u, 0u}, nx = {0u, 0u, 0u, 0u};
        if (t > 0) pv = *(const u32x4*)(p + 384 - 768);
        if (t < L - 1) nx = *(const u32x4*)(p + 384 + 768);
        u32x4 d;
#pragma unroll
        for (int j = 0; j < 4; ++j) {
            float lo = bflo(base[j]) + 0.5f * (bflo(pv[j]) + bflo(nx[j])) - bflo(cur[j]), hi = bfhi(base[j]) + 0.5f * (bfhi(pv[j]) + bfhi(nx[j])) - bfhi(cur[j]);
            if (c < 128) { lo = 1.f - 2.f / (1.f + __expf(2.f * lo)); hi = 1.f - 2.f / (1.f + __expf(2.f * hi)); }
            else if (c >= 256) { lo = sigmoidf_(lo); hi = sigmoidf_(hi); }
            d[j] = cvt_pk_bf16(lo, hi);
        }
        *(u32x4*)(L1 + row * 384 + c) = d;
    }
}

struct RwRaw { u32x2 r[3], k[3], v[3], ew, a; };
__device__ __forceinline__ void rw_rowinfo(int dir, int b, int gs, size_t& row, bool& hasp, bool& hasn, bool& islat) {
    if (gs < 256) { const int t = dir == 0 ? gs : 255 - gs; row = (size_t)TL + b * 256 + t; hasp = t > 0; hasn = t < 255; islat = false; }
    else { const int t = dir == 0 ? gs - 256 : 8191 - (gs - 256); row = (size_t)b * 8192 + t; hasp = t > 0; hasn = t < 8191; islat = true; }
}
__device__ __forceinline__ void rw_loadA(RwRaw& R, const bf16_t* z, const bf16_t* EWA, int dir, int b, int h, int gs, int cq) {
    size_t row; bool hp, hn, il; rw_rowinfo(dir, b, gs, row, hp, hn, il);
    const bf16_t* p = z + row * 6144 + 2048 + h * 64 + cq * 4;
    const u32x2 zz = {0u, 0u};
    R.r[1] = *(const u32x2*)p; R.k[1] = *(const u32x2*)(p + 1024); R.v[1] = *(const u32x2*)(p + 2048);
    R.r[0] = hp ? *(const u32x2*)(p - 6144) : zz; R.k[0] = hp ? *(const u32x2*)(p - 6144 + 1024) : zz; R.v[0] = hp ? *(const u32x2*)(p - 6144 + 2048) : zz;
    R.r[2] = hn ? *(const u32x2*)(p + 6144) : zz; R.k[2] = hn ? *(const u32x2*)(p + 6144 + 1024) : zz; R.v[2] = hn ? *(const u32x2*)(p + 6144 + 2048) : zz;
    const bf16_t* e = EWA + row * 4096 + dir * 1024 + h * 64 + cq * 4;
    R.ew = *(const u32x2*)e; R.a = *(const u32x2*)(e + 2048);
}
__device__ __forceinline__ void un4(const u32x2 u, float* f) { f[0] = bflo(u[0]); f[1] = bfhi(u[0]); f[2] = bflo(u[1]); f[3] = bfhi(u[1]); }
constexpr int RW_BUF = 49664;
__device__ __forceinline__ void rw_stageB(const RwRaw& R, float* buf, int s_ld, int cq, int dir, int b, int h, int rh, int gs, float* BONUS,
                                          const float (&mu0)[4], const float (&mu1)[4], const float (&mu2)[4], const float (&kk_)[4], const float (&ka_)[4], const float (&rk_)[4]) {
    size_t row; bool hp, hn, il; rw_rowinfo(dir, b, gs, row, hp, hn, il);
    float rp[4], rc[4], rn[4], kp[4], kc[4], kn[4], vp[4], vc[4], vn[4], ew[4], aa[4];
    un4(R.r[0], rp); un4(R.r[1], rc); un4(R.r[2], rn); un4(R.k[0], kp); un4(R.k[1], kc); un4(R.k[2], kn); un4(R.v[0], vp); un4(R.v[1], vc); un4(R.v[2], vn); un4(R.ew, ew); un4(R.a, aa);
    f32x4 wv, kkv, kav, kdv, wrv, vv; float n2 = 0.f, bon = 0.f, cc = 0.f; float kr[4], rr[4];
#pragma unroll
    for (int e = 0; e < 4; ++e) {
        const float r_ = rc[e] + mu0[e] * (0.5f * (rp[e] + rn[e]) - rc[e]);
        const float k_ = kc[e] + mu1[e] * (0.5f * (kp[e] + kn[e]) - kc[e]);
        const float v_ = vc[e] + mu2[e] * (0.5f * (vp[e] + vn[e]) - vc[e]);
        kr[e] = k_ * kk_[e]; n2 += kr[e] * kr[e];
        const float kd = k_ * (1.f + (aa[e] - 1.f) * ka_[e]);
        wv[e] = __expf(-ew[e]); kdv[e] = kd; rr[e] = r_; wrv[e] = wv[e] * r_; vv[e] = v_; bon += r_ * kd * rk_[e]; cc += kd * r_;
    }
    n2 = sum16(n2); bon = sum16(bon);
    const float inv = 1.f / fmaxf(sqrtf(n2), 1e-12f);
    float bb = 0.f;
#pragma unroll
    for (int e = 0; e < 4; ++e) { kkv[e] = kr[e] * inv; kav[e] = kkv[e] * aa[e]; bb += kav[e] * rr[e]; }
    bb = sum16(bb); cc = sum16(cc);
    float* bs = buf + s_ld * 64 + cq * 4;
    *(f32x4*)bs = wv; *(f32x4*)(bs + 2048) = kkv; *(f32x4*)(bs + 4096) = kav; *(f32x4*)(bs + 6144) = kdv; *(f32x4*)(bs + 8192) = wrv; *(f32x4*)(bs + 10240) = vv;
    if (cq == 0) { buf[12288 + 2 * s_ld] = bb; buf[12289 + 2 * s_ld] = cc; }
    if (il && rh == 0 && cq == 0) BONUS[(row * 16 + h) * 2 + dir] = bon;
}
__device__ __forceinline__ void rwkv_scan(const PP& P, unsigned char* shm, const bf16_t* zc, bf16_t* z, const bf16_t* EWA, float* BONUS) {
    const int TIX = opaque_tid(); const int BIX = opaque_bid(); (void)TIX; (void)BIX;
    const int tid = TIX, lane = tid & 63, w = __builtin_amdgcn_readfirstlane(tid >> 6);
    const float* mu = P.in[30]; const float* k_k = P.in[39]; const float* k_a = P.in[40]; const float* r_k = P.in[41];
    for (int task = BIX; task < 256; task += gridDim.x) {
        const int rh = task & 1, dir = (task >> 1) & 1, h = (task >> 2) & 15, b = task >> 6;
        __syncthreads();
        if (w >= 4) {
            const int lt = tid - 256, s0 = lt >> 4, cq = lt & 15, hc = h * 64 + cq * 4;
            float mu0[4], mu1[4], mu2[4], kk_[4], ka_[4], rk_[4];
#pragma unroll
            for (int e = 0; e < 4; ++e) { mu0[e] = mu[hc + e]; mu1[e] = mu[1024 + hc + e]; mu2[e] = mu[2048 + hc + e]; kk_[e] = k_k[hc + e]; ka_[e] = k_a[hc + e]; rk_[e] = r_k[hc + e]; }
            RwRaw R0, R1;
            rw_loadA(R0, zc, EWA, dir, b, h, s0, cq); rw_loadA(R1, zc, EWA, dir, b, h, s0 + 16, cq);
            for (int ci = -1; ci < 264; ++ci) {
                if (ci + 1 < 264) {
                    float* buf = (float*)(shm + ((ci + 1) & 1) * RW_BUF);
                    rw_stageB(R0, buf, s0, cq, dir, b, h, rh, (ci + 1) * 32 + s0, BONUS, mu0, mu1, mu2, kk_, ka_, rk_);
                    rw_stageB(R1, buf, s0 + 16, cq, dir, b, h, rh, (ci + 1) * 32 + s0 + 16, BONUS, mu0, mu1, mu2, kk_, ka_, rk_);
                    if (ci + 2 < 264) { rw_loadA(R0, zc, EWA, dir, b, h, (ci + 2) * 32 + s0, cq); rw_loadA(R1, zc, EWA, dir, b, h, (ci + 2) * 32 + s0 + 16, cq); }
                }
                __syncthreads();
            }
        } else {
            const int rp = lane >> 4, cs = lane & 15, vrow0 = rh * 32 + w * 8 + rp * 2;
            f32x2_t Sp[4];
#pragma unroll
            for (int j = 0; j < 4; ++j) Sp[j] = (f32x2_t){0.f, 0.f};
            for (int ci = -1; ci < 264; ++ci) {
                if (ci >= 0) {
                    const float* buf = (const float*)(shm + (ci & 1) * RW_BUF);
                    const bool islat = ci >= 8;
                    const float* bq = buf + cs * 4;
                    f32x4 w4 = *(const f32x4*)bq, kk4 = *(const f32x4*)(bq + 2048), ka4 = *(const f32x4*)(bq + 4096), kd4 = *(const f32x4*)(bq + 6144), wr4 = *(const f32x4*)(bq + 8192);
                    f32x2_t v2 = *(const f32x2_t*)(buf + 10240 + vrow0), bc = *(const f32x2_t*)(buf + 12288);
                    float yk0 = 0.f, yk1 = 0.f;
#pragma unroll
                    for (int s = 0; s < 32; ++s) {
                        const f32x4 cw = w4, ckk = kk4, cka = ka4, ckd = kd4, cwr = wr4; const f32x2_t cv = v2, cbc = bc;
                        if (s + 1 < 32) { const float* bn = bq + (s + 1) * 64;
                            w4 = *(const f32x4*)bn; kk4 = *(const f32x4*)(bn + 2048); ka4 = *(const f32x4*)(bn + 4096); kd4 = *(const f32x4*)(bn + 6144); wr4 = *(const f32x4*)(bn + 8192);
                            v2 = *(const f32x2_t*)(buf + 10240 + (s + 1) * 64 + vrow0); bc = *(const f32x2_t*)(buf + 12288 + 2 * (s + 1)); }
                        f32x2_t sa = Sp[0] * ckk[0], A = Sp[0] * cwr[0];
#pragma unroll
                        for (int j = 1; j < 4; ++j) { sa += Sp[j] * ckk[j]; A += Sp[j] * cwr[j]; }
                        float sa0 = sa[0], sa1 = sa[1], A0 = A[0], A1 = A[1];
                        asm volatile(
                            "s_nop 1\n"
                            "v_add_f32_dpp %0, %0, %0 quad_perm:[1,0,3,2] row_mask:0xf bank_mask:0xf bound_ctrl:1\n"
                            "v_add_f32_dpp %1, %1, %1 quad_perm:[1,0,3,2] row_mask:0xf bank_mask:0xf bound_ctrl:1\n"
                            "v_add_f32_dpp %2, %2, %2 quad_perm:[1,0,3,2] row_mask:0xf bank_mask:0xf bound_ctrl:1\n"
                            "v_add_f32_dpp %3, %3, %3 quad_perm:[1,0,3,2] row_mask:0xf bank_mask:0xf bound_ctrl:1\n"
                            "v_add_f32_dpp %0, %0, %0 quad_perm:[2,3,0,1] row_mask:0xf bank_mask:0xf bound_ctrl:1\n"
                            "v_add_f32_dpp %1, %1, %1 quad_perm:[2,3,0,1] row_mask:0xf bank_mask:0xf bound_ctrl:1\n"
                            "v_add_f32_dpp %2, %2, %2 quad_perm:[2,3,0,1] row_mask:0xf bank_mask:0xf bound_ctrl:1\n"
                            "v_add_f32_dpp %3, %3, %3 quad_perm:[2,3,0,1] row_mask:0xf bank_mask:0xf bound_ctrl:1\n"
                            "v_add_f32_dpp %0, %0, %0 row_half_mirror row_mask:0xf bank_mask:0xf bound_ctrl:1\n"
                            "v_add_f32_dpp %1, %1, %1 row_half_mirror row_mask:0xf bank_mask:0xf bound_ctrl:1\n"
                            "v_add_f32_dpp %2, %2, %2 row_half_mirror row_mask:0xf bank_mask:0xf bound_ctrl:1\n"
                            "v_add_f32_dpp %3, %3, %3 row_half_mirror row_mask:0xf bank_mask:0xf bound_ctrl:1\n"
                            "v_add_f32_dpp %0, %0, %0 row_ror:8 row_mask:0xf bank_mask:0xf bound_ctrl:1\n"
                            "v_add_f32_dpp %1, %1, %1 row_ror:8 row_mask:0xf bank_mask:0xf bound_ctrl:1\n"
                            "v_add_f32_dpp %2, %2, %2 row_ror:8 row_mask:0xf bank_mask:0xf bound_ctrl:1\n"
                            "v_add_f32_dpp %3, %3, %3 row_ror:8 row_mask:0xf bank_mask:0xf bound_ctrl:1\n"
                            "s_nop 0\n"
                            : "+v"(sa0), "+v"(sa1), "+v"(A0), "+v"(A1));
                        sa = (f32x2_t){sa0, sa1}; A = (f32x2_t){A0, A1};
#pragma unroll
                        for (int j = 0; j < 4; ++j) Sp[j] = Sp[j] * cw[j] - sa * cka[j] + cv * ckd[j];
                        const f32x2_t yv = A - sa * cbc[0] + cv * cbc[1];
                        const float y0 = yv[0], y1 = yv[1];
                        const bool mine = (s & 15) == cs;
                        yk0 = mine ? y0 : yk0; yk1 = mine ? y1 : yk1;
                        if ((s & 15) == 15 && islat) {
                            const int gs = ci * 32 + (s & 16) + cs; const int t = dir == 0 ? gs - 256 : 8191 - (gs - 256);
                            *(unsigned*)(z + ((size_t)b * 8192 + t) * 6144 + (dir == 0 ? 5120 : 1024) + h * 64 + vrow0) = cvt_pk_bf16(yk0, yk1);
                        }
                    }
                }
                __syncthreads();
            }
        }
    }
}
__device__ __forceinline__ void rwkv_post(const PP& P, const bf16_t* z, const bf16_t* G, const float* BONUS, bf16_t* o) {
    const int TIX = opaque_tid(); const int BIX = opaque_bid(); (void)TIX; (void)BIX;
    const int lane = TIX & 63, cq = lane & 15;
    const size_t gw = (size_t)BIX * 8 + (TIX >> 6), nw = (size_t)gridDim.x * 8;
    const float* mu = P.in[30]; const float* lg = P.in[42]; const float* lb = P.in[43];
    for (size_t it = gw * 4 + (lane >> 4); it < (size_t)TL * 16; it += nw * 4) {
        const size_t row = it >> 4; const int h = (int)(it & 15), hc = h * 64 + cq * 4; const int t = (int)(row & 8191);
        float yf[4], yb[4], y[4];
        un4(*(const u32x2*)(z + row * 6144 + 5120 + hc), yf); un4(*(const u32x2*)(z + row * 6144 + 1024 + hc), yb);
        float s = 0.f;
#pragma unroll
        for (int e = 0; e < 4; ++e) { y[e] = yf[e] + yb[e]; s += y[e]; }
        const float mean = sum16(s) * (1.f / 64.f);
        float q = 0.f;
#pragma unroll
        for (int e = 0; e < 4; ++e) { y[e] -= mean; q += y[e] * y[e]; }
        const float rstd = rsqrtf(sum16(q) * (1.f / 64.f) + 64e-5f);
        float vc[4], vp[4] = {0.f, 0.f, 0.f, 0.f}, vn[4] = {0.f, 0.f, 0.f, 0.f}, gg[4];
        const bf16_t* pv = z + row * 6144 + 4096 + hc;
        un4(*(const u32x2*)pv, vc);
        if (t > 0) un4(*(const u32x2*)(pv - 6144), vp);
        if (t < 8191) un4(*(const u32x2*)(pv + 6144), vn);
        un4(*(const u32x2*)(G + row * 1024 + hc), gg);
        const float bs = BONUS[(row * 16 + h) * 2] + BONUS[(row * 16 + h) * 2 + 1];
        float out[4];
#pragma unroll
        for (int e = 0; e < 4; ++e) { const float v_ = vc[e] + mu[2048 + hc + e] * (0.5f * (vp[e] + vn[e]) - vc[e]);
            out[e] = (y[e] * rstd * lg[hc + e] + lb[hc + e] + bs * v_) * gg[e]; }
        u32x2 pk; pk[0] = cvt_pk_bf16(out[0], out[1]); pk[1] = cvt_pk_bf16(out[2], out[3]);
        *(u32x2*)(o + row * 2048 + 1024 + hc) = pk;
    }
}


#ifdef DEBUG_CHECKS
__device__ __forceinline__ void chk_flag(unsigned* flags, int bit, float a, float b) { if (!(fabsf(a - b) <= 0.04f * (fabsf(a) + fabsf(b)) + 0.02f)) atomicOr(flags, 1u << bit); }
__device__ __forceinline__ void chk_gemm(const PP& P, const bf16_t* hn, const bf16_t* z, unsigned* flags) {
    const int lane = opaque_tid() & 63;
    const int rows[3] = {12345, 33000, 255}; const int cols[3] = {2222, 17, 4095};
    for (int s = 0; s < 3; ++s) { float a = 0.f;
        for (int k = lane; k < 2048; k += 64) a += bf2f(hn[(size_t)rows[s] * 2048 + k]) * P.in[10][(size_t)k * 4096 + cols[s]];
        a = wave_sum(a); chk_flag(flags, 5, a, bf2f(z[(size_t)rows[s] * 4096 + cols[s]])); }
}
__device__ __forceinline__ void chk_s5(const PP& P, const bf16_t* z, const bf16_t* o, unsigned* flags) {
    const int lane = opaque_tid() & 63, b = 1, g = 5;
    float part[2][16];
#pragma unroll
    for (int k = 0; k < 2; ++k)
#pragma unroll
        for (int p = 0; p < 16; ++p) part[k][p] = 0.f;
    const size_t trow[2] = {(size_t)TL + b * 256 + 100, (size_t)b * 8192 + 3000};
    for (int dir = 0; dir < 2; ++dir) {
        const int dg = dir * 64 + g; const float dt = expf(P.in[17][dg]);
        const float are = P.in[15][dg * 64 + lane], aim = P.in[16][dg * 64 + lane]; const float mag = expf(are * dt);
        const float lre = mag * cosf(aim * dt), lim = mag * sinf(aim * dt);
        const float nr = lre - 1.f, ni = lim, den = 1.f / (are * are + aim * aim);
        const float cre = (nr * are + ni * aim) * den, cim = (ni * are - nr * aim) * den;
        float bbr[16], bbi[16], ccr[16], cci[16];
#pragma unroll
        for (int p = 0; p < 16; ++p) { const float br = P.in[18][((size_t)dg * 64 + lane) * 16 + p], bi = P.in[19][((size_t)dg * 64 + lane) * 16 + p];
            bbr[p] = cre * br - cim * bi; bbi[p] = cre * bi + cim * br;
            ccr[p] = P.in[20][((size_t)dg * 16 + p) * 64 + lane]; cci[p] = P.in[21][((size_t)dg * 16 + p) * 64 + lane]; }
        float xr = 0.f, xi = 0.f;
        for (int pos = 0; pos < 8448; ++pos) {
            size_t row; if (pos < 256) row = (size_t)TL + b * 256 + (dir == 0 ? pos : 255 - pos); else row = (size_t)b * 8192 + (dir == 0 ? pos - 256 : 8191 - (pos - 256));
            float bur = 0.f, bui = 0.f;
#pragma unroll
            for (int p = 0; p < 16; ++p) { const float u = bf2f(z[row * 4096 + g * 16 + p]); bur += bbr[p] * u; bui += bbi[p] * u; }
            const float n1 = lre * xr - lim * xi + bur, n2 = lre * xi + lim * xr + bui; xr = n1; xi = n2;
#pragma unroll
            for (int k = 0; k < 2; ++k) if (row == trow[k]) {
#pragma unroll
                for (int p = 0; p < 16; ++p) part[k][p] += ccr[p] * xr - cci[p] * xi; }
        }
    }
#pragma unroll
    for (int k = 0; k < 2; ++k) {
        float ge[16];
#pragma unroll
        for (int p = 0; p < 16; ++p) { const float y = wave_sum(part[k][p]) + P.in[22][g * 16 + p] * bf2f(z[trow[k] * 4096 + g * 16 + p]); ge[p] = gelu_tanh(y); }
        const int q = lane & 15; float val = P.in[24][g * 16 + q], gt = P.in[24][(64 + g) * 16 + q];
#pragma unroll
        for (int p = 0; p < 16; ++p) { val += ge[p] * P.in[23][((size_t)g * 16 + p) * 16 + q]; gt += ge[p] * P.in[23][((size_t)(64 + g) * 16 + p) * 16 + q]; }
        chk_flag(flags, 0, val * sigmoidf_(gt), bf2f(o[trow[k] * 2048 + g * 16 + q]));
    }
}
__device__ __forceinline__ void chk_attn(const PP& P, unsigned char* wl, const bf16_t* z, const bf16_t* o, unsigned* flags) {
    const int lane = opaque_tid() & 63;
    float* pbuf = (float*)wl; int* kbuf = (int*)(wl + 2048);
    for (int s = 0; s < 8; ++s) {
        const int b = 0, h = 0, r = 0, col = s; const bool band = true;
        const size_t qrow = band ? (size_t)b * 8192 + r * 64 + col : (size_t)TL + b * 256 + col;
        const int start = min(max(r - 4, 0), 120), cs = min(max(col - 8, 0), 48);
        float sc[6]; int kr[6]; float m = -1e30f;
#pragma unroll
        for (int kk = 0; kk < 6; ++kk) {
            float bias = 0.f; bool valid = true; size_t krow;
            if (kk < 2) { const int kidx = kk * 64 + lane, jr = kidx >> 4, jc = kidx & 15; krow = (size_t)b * 8192 + (start + jr) * 64 + cs + jc; bias = P.in[25][(h * 15 + start + jr - r + 7) * 31 + (cs + jc - col + 15)]; valid = band; }
            else krow = (size_t)TL + b * 256 + (kk - 2) * 64 + lane;
            float d = 0.f;
            for (int e = 0; e < 64; ++e) d += bf2f(z[qrow * 4096 + 1024 + h * 64 + e]) * bf2f(z[krow * 4096 + 2048 + h * 64 + e]);
            sc[kk] = valid ? d * 0.125f + bias : -1e30f; kr[kk] = (int)krow; m = fmaxf(m, sc[kk]);
        }
#pragma unroll
        for (int o2 = 32; o2 > 0; o2 >>= 1) m = fmaxf(m, __shfl_xor(m, o2));
        float l = 0.f;
#pragma unroll
        for (int kk = 0; kk < 6; ++kk) { const float p = expf(sc[kk] - m); l += p; pbuf[kk * 64 + lane] = p; kbuf[kk * 64 + lane] = kr[kk]; }
        l = wave_sum(l);
        WAVE_SYNC();
        float acc = 0.f;
        for (int i = 0; i < 384; ++i) acc += pbuf[i] * bf2f(z[(size_t)kbuf[i] * 4096 + 3072 + h * 64 + lane]);
        { const float a_ = acc / l, b_ = bf2f(o[qrow * 2048 + 1024 + h * 64 + lane]); float e_ = fabsf(a_ - b_), m_ = fabsf(a_);
#pragma unroll
            for (int o2 = 32; o2 > 0; o2 >>= 1) { e_ = fmaxf(e_, __shfl_xor(e_, o2)); m_ = fmaxf(m_, __shfl_xor(m_, o2)); }
            if (lane == 0 && e_ > 0.2f * m_) atomicOr(flags, 1u << s); }
        WAVE_SYNC();
    }
}
__device__ __forceinline__ void chk_sgu(const PP& P, const bf16_t* z, const bf16_t* o, unsigned* flags) {
    const int lane = opaque_tid() & 63, b = 1, t = 4321, n = t >> 7, p = t & 127, c = 717, h = c >> 7;
    float acc = 0.f;
    for (int q = 0; q < 128; ++q) {
        const size_t row = (size_t)b * 8192 + n * 128 + q;
        float v[16]; float s = 0.f;
#pragma unroll
        for (int j = 0; j < 16; ++j) { v[j] = gelu_tanh(bf2f(z[row * 6144 + 1024 + j * 64 + lane])); s += v[j]; }
        const float mean = wave_sum(s) * (1.f / 1024.f); float qq = 0.f;
#pragma unroll
        for (int j = 0; j < 16; ++j) qq += (v[j] - mean) * (v[j] - mean);
        const float rstd = rsqrtf(wave_sum(qq) * (1.f / 1024.f) + 1e-5f);
        const float vc = (gelu_tanh(bf2f(z[row * 6144 + 1024 + c])) - mean) * rstd * P.in[26][c] + P.in[27][c];
        acc += P.in[28][((size_t)h * 128 + p) * 128 + q] * vc;
    }
    const size_t row = (size_t)b * 8192 + t;
    chk_flag(flags, 4, gelu_tanh(bf2f(z[row * 6144 + c])) * (acc + P.in[29][h * 128 + p]), bf2f(o[row * 2048 + c]));
}
__device__ __forceinline__ void chk_lora(const PP& P, unsigned char* wl, const bf16_t* z, const bf16_t* EWA, const bf16_t* G, unsigned* flags) {
    const int lane = opaque_tid() & 63, dir = 1, ch = 300; const size_t row = (size_t)8192 + 777;
    float* lbuf = (float*)wl;
    float xd[16], dx[16];
#pragma unroll
    for (int j = 0; j < 16; ++j) { const int k = j * 64 + lane; xd[j] = bf2f(z[row * 6144 + 5120 + k]);
        dx[j] = 0.5f * (bf2f(z[(row - 1) * 6144 + 5120 + k]) + bf2f(z[(row + 1) * 6144 + 5120 + k])) - xd[j]; }
    for (int jj = 0; jj < 64; ++jj) { float a = 0.f;
#pragma unroll
        for (int j = 0; j < 16; ++j) { const int k = j * 64 + lane; a += (xd[j] + P.in[30][3 * 1024 + k] * dx[j]) * P.in[32][((size_t)dir * 1024 + k) * 64 + jj]; }
        a = wave_sum(a); if (lane == jj) lbuf[jj] = tanhf(a); }
    WAVE_SYNC();
    { float pre = wave_sum(lbuf[lane] * P.in[33][((size_t)dir * 64 + lane) * 1024 + ch]) + P.in[31][dir * 1024 + ch];
      const float x = -pre; const float sp = x > 20.f ? x : log1pf(expf(x));
      chk_flag(flags, 5, expf(-sp - 0.5f), bf2f(EWA[row * 4096 + dir * 1024 + ch])); }
    WAVE_SYNC();
    for (int jj = 0; jj < 64; ++jj) { float a = 0.f;
#pragma unroll
        for (int j = 0; j < 16; ++j) { const int k = j * 64 + lane; a += (xd[j] + P.in[30][4 * 1024 + k] * dx[j]) * P.in[35][((size_t)dir * 1024 + k) * 64 + jj]; }
        a = wave_sum(a); if (lane == jj) lbuf[jj] = a; }
    WAVE_SYNC();
    { const float pre = wave_sum(lbuf[lane] * P.in[36][((size_t)dir * 64 + lane) * 1024 + ch]) + P.in[34][dir * 1024 + ch];
      chk_flag(flags, 5, sigmoidf_(pre), bf2f(EWA[row * 4096 + 2048 + dir * 1024 + ch])); }
    WAVE_SYNC();
    for (int jj = 0; jj < 128; ++jj) { float a = 0.f;
#pragma unroll
        for (int j = 0; j < 16; ++j) { const int k = j * 64 + lane; a += (xd[j] + P.in[30][5 * 1024 + k] * dx[j]) * P.in[37][(size_t)k * 128 + jj]; }
        a = wave_sum(a); if (lane == (jj & 63)) lbuf[jj] = sigmoidf_(a); }
    WAVE_SYNC();
    { const float gsum = wave_sum(lbuf[lane] * P.in[38][(size_t)lane * 1024 + ch] + lbuf[64 + lane] * P.in[38][(size_t)(64 + lane) * 1024 + ch]);
      chk_flag(flags, 5, gsum, bf2f(G[row * 1024 + ch])); }
    WAVE_SYNC();
}
__device__ __forceinline__ void chk_rwkv(const PP& P, unsigned char* wl, const bf16_t* z, const bf16_t* EWA, unsigned* flags) {
    const int lane = opaque_tid() & 63, b = 1, h = 3, hc = h * 64 + lane;
    float* L = (float*)wl;
    for (int dir = 0; dir < 2; ++dir) {
        float S[64];
#pragma unroll
        for (int k = 0; k < 64; ++k) S[k] = 0.f;
        for (int gs = 0; gs < 258; ++gs) {
            size_t row; bool hp, hn, il; rw_rowinfo(dir, b, gs, row, hp, hn, il);
            const bf16_t* p = z + row * 6144 + 2048 + hc;
            float rr = bf2f(p[0]), kq = bf2f(p[1024]), vv = bf2f(p[2048]);
            const float rp = hp ? bf2f(p[-6144]) : 0.f, kp = hp ? bf2f(p[-6144 + 1024]) : 0.f, vp = hp ? bf2f(p[-6144 + 2048]) : 0.f;
            const float rn = hn ? bf2f(p[6144]) : 0.f, kn = hn ? bf2f(p[6144 + 1024]) : 0.f, vn = hn ? bf2f(p[6144 + 2048]) : 0.f;
            rr += P.in[30][hc] * (0.5f * (rp + rn) - rr); kq += P.in[30][1024 + hc] * (0.5f * (kp + kn) - kq); vv += P.in[30][2048 + hc] * (0.5f * (vp + vn) - vv);
            float kk = kq * P.in[39][hc]; const float nn = wave_sum(kk * kk); kk = kk / fmaxf(sqrtf(nn), 1e-12f);
            const float ew = bf2f(EWA[row * 4096 + dir * 1024 + hc]), a = bf2f(EWA[row * 4096 + 2048 + dir * 1024 + hc]);
            L[lane] = expf(-ew); L[64 + lane] = kk; L[128 + lane] = kk * a; L[192 + lane] = kq * (1.f + (a - 1.f) * P.in[40][hc]); L[256 + lane] = rr; L[320 + lane] = vv;
            WAVE_SYNC();
            float sa = 0.f;
#pragma unroll
            for (int k = 0; k < 64; ++k) sa += S[k] * L[64 + k];
            float y = 0.f;
#pragma unroll
            for (int k = 0; k < 64; ++k) { S[k] = S[k] * L[k] - sa * L[128 + k] + vv * L[192 + k]; y += S[k] * L[256 + k]; }
            if (il) chk_flag(flags, 4, y, bf2f(z[row * 6144 + (dir == 0 ? 5120 : 1024) + hc]));
            WAVE_SYNC();
        }
    }
}
#endif


#define XB_TMO      128
#define XB_XCNT(j)  (256  + 64 * (j))
#define XB_XSUB(j)  (1280 + 64 * (j))
#define XB_XGEN(j)  (2304 + 64 * (j))
#define XB_TOP      3328
#define XB_TOPGEN   3392
#define XCD_BAR_WORDS 3456
#define XB_SPIN_CAP (1u << 22)
__device__ __forceinline__ unsigned xb_ld(unsigned* p)              { return __hip_atomic_load(p, __ATOMIC_RELAXED, __HIP_MEMORY_SCOPE_AGENT); }
__device__ __forceinline__ unsigned xb_add(unsigned* p, unsigned v) { return __hip_atomic_fetch_add(p, v, __ATOMIC_RELAXED, __HIP_MEMORY_SCOPE_AGENT); }
__device__ __forceinline__ unsigned xb_xcc_id() { return (unsigned)__builtin_amdgcn_s_getreg((3 << 11) | 20) & 0xFu; }
#define XB_SPIN(cond, bar) do { unsigned _sp = 0; while (cond) { __builtin_amdgcn_s_sleep(1); \
    if ((++_sp & 255u) == 0u) { if (xb_ld(&(bar)[XB_TMO])) break; if (_sp > XB_SPIN_CAP) { atomicAdd(&(bar)[XB_TMO], 1u); break; } } } } while (0)
struct XcdBarrier { unsigned* bar; unsigned x; volatile LAS unsigned* st; };
__device__ __forceinline__ XcdBarrier xcd_barrier_post(unsigned* bar, volatile LAS unsigned* st) {
    XcdBarrier b; b.bar = bar; b.x = xb_xcc_id(); b.st = st;
    if (threadIdx.x == 0) (void)xb_add(&bar[XB_XCNT(b.x)], 1u);
    return b;
}
__device__ __forceinline__ void xcd_barrier_complete(unsigned* bar, unsigned x, unsigned& nloc, unsigned& nx) {
    const unsigned G = gridDim.x * gridDim.y * gridDim.z;
    unsigned sum, cnt, mine, sp = 0u;
    for (;;) {
        sum = 0u; cnt = 0u; mine = 0u;
#pragma unroll
        for (unsigned j = 0; j < 16; ++j) { const unsigned c = xb_ld(&bar[XB_XCNT(j)]); sum += c; cnt += (c > 0u) ? 1u : 0u; mine = (j == x) ? c : mine; }
        if (sum == G) break;
        __builtin_amdgcn_s_sleep(1);
        if ((++sp & 255u) == 0u) { if (xb_ld(&bar[XB_TMO])) break; if (sp > XB_SPIN_CAP) { atomicAdd(&bar[XB_TMO], 1u); break; } }
    }
    nloc = mine > 0u ? mine : 1u; nx = cnt > 0u ? cnt : 1u;
}
__device__ __forceinline__ void xcd_barrier(const XcdBarrier& b) {
    asm volatile("s_waitcnt vmcnt(0)" ::: "memory");
    __syncthreads();
    if (threadIdx.x == 0) {
        unsigned* bar = b.bar;
        __builtin_amdgcn_s_waitcnt(0);
        unsigned nloc = b.st[0], nx = b.st[1];
        if (nloc == 0u) { xcd_barrier_complete(bar, b.x, nloc, nx); b.st[0] = nloc; b.st[1] = nx; }
        const unsigned old = xb_add(&bar[XB_XSUB(b.x)], 1u);
        const unsigned gen = old / nloc;
        if (old + 1u == (gen + 1u) * nloc) {
            __builtin_amdgcn_fence(__ATOMIC_RELEASE, "agent");
            asm volatile("s_waitcnt vmcnt(0)" ::: "memory");
            const unsigned og = xb_add(&bar[XB_TOP], 1u);
            const unsigned tg = og / nx;
            if (og + 1u == (tg + 1u) * nx) xb_add(&bar[XB_TOPGEN], 1u);
            else XB_SPIN(xb_ld(&bar[XB_TOPGEN]) == tg, bar);
            __builtin_amdgcn_fence(__ATOMIC_ACQUIRE, "agent");
            xb_add(&bar[XB_XGEN(b.x)], 1u);
            asm volatile("s_waitcnt vmcnt(0)" ::: "memory");
        } else {
            XB_SPIN(xb_ld(&bar[XB_XGEN(b.x)]) == gen, bar);
            __builtin_amdgcn_fence(__ATOMIC_ACQUIRE, "agent");
            asm volatile("s_waitcnt vmcnt(0)" ::: "memory");
        }
    }
    __syncthreads();
}

__global__ void __launch_bounds__(512, 2) fwd_megakernel(Params P0) {
    extern __shared__ __attribute__((aligned(16))) unsigned char shm[];
    cg::grid_group grid = cg::this_grid();
    unsigned char* ws = P0.ws;
    volatile LAS unsigned* xb_st = (volatile LAS unsigned*)(LAS unsigned char*)(shm + 131072);
    if (threadIdx.x < 4) xb_st[threadIdx.x] = 0u;
    __syncthreads();
    const XcdBarrier xb = xcd_barrier_post((unsigned*)(ws + OFF_BAR), xb_st);
    const int nw = gridDim.x * 8;
#define GW0 (opaque_bid() * 8 + (opaque_tid() >> 6))
#define WL (shm + (opaque_tid() >> 6) * 13312)
    bf16_t* R1 = (bf16_t*)(ws + OFF_R1); bf16_t* R2 = (bf16_t*)(ws + OFF_R2); bf16_t* R3 = (bf16_t*)(ws + OFF_R3);
    float* XC = (float*)(ws + OFF_XC);

    prologue(P0, shm);
    { const int t_ = opaque_tid(); if (opaque_bid() == 0 && t_ == 64) *(unsigned*)(ws + OFF_TBL + 4096) = 0u; if (opaque_bid() == 0 && t_ < 44) ((const float**)(ws + OFF_TBL))[t_] = P0.in[t_]; }
    grid.sync();
    PP P; P.in = (const float* const*)(ws + OFF_TBL); P.out = P0.out; P.ws = ws;
    resid_mod(P, TT, P.in[0], P.in[2], nullptr, nullptr, nullptr, nullptr, 0, 0, 0, P.in[6], 0, 2048, R2);
    xcd_barrier(xb);
    run_gemm<EPI_PLAIN>(shm, R2, (const bf16_t*)(ws + WB_WINE), TT, 4096, 2048, R1, 4096);
    xcd_barrier(xb);
#ifdef DEBUG_CHECKS
    unsigned* flags = (unsigned*)(ws + OFF_TBL + 4096);
    xcd_barrier(xb);
#endif
    {   float2* E = (float2*)(ws + OFF_S5E); bf16_t* VT = (bf16_t*)(ws + OFF_VT); bf16_t* VCT = (bf16_t*)(ws + OFF_VCT);
        for (int t = GW0; t < 4 * 64 * 132; t += nw) s5_task<false>(P, t, WL, R1, E, R3);
        for (int t = GW0; t < 528 * 16; t += nw) vt_task(t, WL, R1, VT, VCT);
        xcd_barrier(xb);
        s5_carry(P, E);
#ifdef NAIVE_ATTN
        for (int t = GW0; t < 4 * 8192 * 16; t += nw) attn_naive(P, t, WL, R1, R3, true);
        for (int t = GW0; t < 4 * 256 * 16; t += nw) attn_naive(P, t, WL, R1, R3, false);
#else
        if (nw == 2048) {
            bf16_t* KL = (bf16_t*)(shm + 20480); bf16_t* VL = (bf16_t*)(shm + 20480 + 36864);
            for (int it = 0; it < 16; ++it) {
                const int tid_ = opaque_tid(), bid_ = opaque_bid();
                const int vb = (bid_ & 7) * 32 + (bid_ >> 3);
                const int tb = vb * 8 + it * 2048, hh = (tb >> 9) & 15, bb = tb >> 13;
                __syncthreads();
#pragma unroll
                for (int i = 0; i < 4; ++i) { const int idx = tid_ + i * 512, key = idx >> 3, part = idx & 7;
                    *(u32x4*)(KL + key * 72 + part * 8) = *(const u32x4*)(R1 + ((size_t)TL + bb * 256 + key) * 4096 + 2048 + hh * 64 + part * 8); }
#pragma unroll
                for (int i = 0; i < 4; ++i) { const int idx = tid_ + i * 512, d = idx >> 5, part = idx & 31;
                    *(u32x4*)(VL + d * 264 + part * 8) = *(const u32x4*)(VCT + ((size_t)(bb * 16 + hh) * 64 + d) * 256 + part * 8); }
                __syncthreads();
                attn_task<true>(P, tb + (tid_ >> 6), shm + (tid_ >> 6) * 2560, R1, VT, VCT, R3, KL, VL);
            }
            __syncthreads();
        } else
        for (int t = GW0; t < 32768; t += nw) attn_task<true>(P, t, WL, R1, VT, VCT, R3);
        for (int t = GW0; t < 1024; t += nw) attn_task<false>(P, t, WL, R1, VT, VCT, R3);
#endif
        xcd_barrier(xb);
        for (int t = GW0; t < 4 * 64 * 132; t += nw) s5_task<true>(P, t, WL, R1, E, R3);
        xcd_barrier(xb);
#ifdef DEBUG_CHECKS
        if (opaque_bid() == 2 && opaque_tid() < 64) chk_attn(P, shm, R1, R3, flags);
        xcd_barrier(xb);
#endif
    }
    run_gemm<EPI_PLAIN>(shm, R3, (const bf16_t*)(ws + WB_WOUT0), TT, 2048, 2048, R1, 2048);
    xcd_barrier(xb);
    resid_mod(P, TT, P.in[0], P.in[2], P.out, XC, R1, P.in[7], 2 * 2048, 0, 0, P.in[8], 3 * 2048, 4 * 2048, R2);
    xcd_barrier(xb);
    run_gemm<EPI_RELU2>(shm, R2, (const bf16_t*)(ws + WB_W1_0), TT, 8192, 2048, R1, 8192);
    xcd_barrier(xb);
    run_gemm<EPI_PLAIN>(shm, R1, (const bf16_t*)(ws + WB_W2_0), TT, 2048, 8192, R3, 2048);
    xcd_barrier(xb);
    resid_mod(P, TT, P.out, XC, P.out, XC, R3, P.in[9], 5 * 2048, 0, 1, P.in[6] + 2048, 0, 2048, R2);
    xcd_barrier(xb);
    run_gemm<EPI_PLAIN>(shm, R2, (const bf16_t*)(ws + WB_WINO), TT, 6144, 2048, R1, 6144);
    xcd_barrier(xb);
    {   bf16_t* VLNT = (bf16_t*)(ws + OFF_VLNT); bf16_t* G = (bf16_t*)(ws + OFF_G); bf16_t* LORA1 = (bf16_t*)(ws + OFF_LORA1); bf16_t* EWA = (bf16_t*)(ws + OFF_EWA);
        float* BONUS = (float*)(ws + OFF_BONUS);
        sgu_pre(P, shm, R1, VLNT);
        xcd_barrier(xb);
        for (int t = GW0; t < 4 * 64 * 8 * 4; t += nw) sgu_task(P, t, R1, VLNT, (const bf16_t*)(ws + OFF_WSB), R3);
        __syncthreads();
        run_gemm<EPI_PLAIN>(shm, R1 + 5120, (const bf16_t*)(ws + OFF_L1T), TT, 768, 1024, R2, 768, nullptr, nullptr, 6144);
        xcd_barrier(xb);
        lora1_combine(R2, LORA1);
        xcd_barrier(xb);
        run_gemm<EPI_LORA2>(shm, LORA1, (const bf16_t*)(ws + OFF_L2T), TT, 5120, 384, EWA, 4096, G, P.in);
        xcd_barrier(xb);
#ifdef DEBUG_CHECKS
        xcd_barrier(xb);
#endif
        rwkv_scan(P, shm, R1, R1, EWA, BONUS);
        xcd_barrier(xb);
        rwkv_post(P, R1, G, BONUS, R3);
        xcd_barrier(xb);
#ifdef DEBUG_CHECKS
        xcd_barrier(xb);
#endif
    }
    run_gemm<EPI_PLAIN>(shm, R3, (const bf16_t*)(ws + WB_WOUT1), TL, 2048, 2048, R1, 2048);
    xcd_barrier(xb);
    resid_mod(P, TL, P.out, XC, P.out, XC, R1, P.in[7] + 2048, 2 * 2048, 1, 1, P.in[8] + 2048, 3 * 2048, 4 * 2048, R2);
    xcd_barrier(xb);
    run_gemm<EPI_RELU2>(shm, R2, (const bf16_t*)(ws + WB_W1_1), TL, 8192, 2048, R1, 8192);
    xcd_barrier(xb);
    run_gemm<EPI_PLAIN>(shm, R1, (const bf16_t*)(ws + WB_W2_1), TL, 2048, 8192, R3, 2048);
    xcd_barrier(xb);
    resid_mod(P, TL, P.out, XC, P.out, XC, R3, P.in[9] + 2048, 5 * 2048, 1, 1, nullptr, 0, 0, nullptr);
#ifdef DEBUG_CHECKS
    xcd_barrier(xb);
    { const unsigned f = *(volatile unsigned*)flags;
      if (f) { float kv = 1.f; for (unsigned i = 0; i < f; ++i) kv *= 1.4f;
          for (size_t i = (size_t)opaque_bid() * 512 + opaque_tid(); i < (size_t)TL * DM; i += (size_t)gridDim.x * 512) P.out[i] = kv; } }
#endif
}

extern "C" void kernel_launch(void* const* d_in, const int* in_sizes, int n_in, void* d_out, int out_size, void* d_ws, size_t ws_size, hipStream_t stream) {
    static int grid_blocks = 0;
    if (grid_blocks == 0) {
        if (n_in != 44 || ws_size < WS_END) { fprintf(stderr, "kernel_launch: unexpected n_in %d / ws_size %zu (need %zu)\n", n_in, ws_size, (size_t)WS_END); grid_blocks = -1; return; }
        int dev = 0, cus = 0, per_cu = 0;
        hipGetDevice(&dev);
        hipDeviceGetAttribute(&cus, hipDeviceAttributeMultiprocessorCount, dev);
        if (hipFuncSetAttribute((const void*)fwd_megakernel, hipFuncAttributeMaxDynamicSharedMemorySize, LDS_BYTES) != hipSuccess) { fprintf(stderr, "kernel_launch: hipFuncSetAttribute failed\n"); grid_blocks = -1; return; }
        hipOccupancyMaxActiveBlocksPerMultiprocessor(&per_cu, (const void*)fwd_megakernel, 512, LDS_BYTES);
        if (per_cu < 1) { fprintf(stderr, "kernel_launch: occupancy query says %d blocks per CU\n", per_cu); per_cu = 1; }
        grid_blocks = cus * per_cu;
    }
    if (grid_blocks < 0) return;
    if (hipMemsetAsync((unsigned char*)d_ws + OFF_BAR, 0, XCD_BAR_WORDS * sizeof(unsigned), stream) != hipSuccess) { fprintf(stderr, "kernel_launch: hipMemsetAsync of the barrier words failed\n"); return; }
    Params p{};
    for (int i = 0; i < 44; ++i) p.in[i] = (const float*)d_in[i];
    p.out = (float*)d_out; p.ws = (unsigned char*)d_ws;
    void* args[] = {&p};
    hipError_t e = hipLaunchCooperativeKernel((const void*)fwd_megakernel, dim3(grid_blocks), dim3(512), args, LDS_BYTES, stream);
    if (e != hipSuccess) fprintf(stderr, "cooperative launch failed: %s (grid %d)\n", hipGetErrorString(e), grid_blocks);
}
```
